# Optimizing an MI355X kernel written in HIP

```python
import math
import jax, jax.numpy as jnp
from jax import lax
import numpy as np

D_MODEL = 1024
BATCH = 2
SEQ = 16384
DEPTH = 1
DEC_BATCH = 4
DEC_SEQ = 8192
PAST_LEN = 128

SSM_WIDTH = D_MODEL // 2
SSM_GROUP_CH = 16
SSM_GROUPS = SSM_WIDTH // SSM_GROUP_CH
SSM_STATE = 64
DT_MIN = 1e-3
DT_MAX = 1e-1
N_HEADS = 8
QK_NOPE = 64
QK_ROPE = 32
V_HEAD = 64
Q_LORA = D_MODEL // 4
KV_LORA = D_MODEL // 8
ATTN_WIDTH = N_HEADS * V_HEAD
ROPE_THETA = 10000.0
Q_BLOCK = 128
LN_EPS = 1e-5
RMS_EPS = 1e-6
ALPHA = (2.0 * DEPTH) ** 0.25
BETA = (8.0 * DEPTH) ** -0.25

IN_SIZES = (SSM_WIDTH, SSM_WIDTH, Q_LORA, KV_LORA, QK_ROPE, ATTN_WIDTH, D_MODEL, D_MODEL)
IN_WIDTH = sum(IN_SIZES)
IN_SPLITS = tuple(int(v) for v in np.cumsum(IN_SIZES)[:-1])

kernel_name = 'hybrid_s5_mla_gated_encoder'

F32 = jnp.float32


def _layer_norm(x, g, b):
    xf = x.astype(F32)
    mu = jnp.mean(xf, -1, keepdims=True)
    var = jnp.mean(jnp.square(xf - mu), -1, keepdims=True)
    y = (xf - mu) * lax.rsqrt(var + LN_EPS) * g.astype(F32) + b.astype(F32)
    return y.astype(x.dtype)


def _rms_norm(x, g):
    xf = x.astype(F32)
    y = xf * lax.rsqrt(jnp.mean(xf * xf, -1, keepdims=True) + RMS_EPS) * g.astype(F32)
    return y.astype(x.dtype)


def _rope(x, pos):
    half = x.shape[-1] // 2
    inv = ROPE_THETA ** (-jnp.arange(half, dtype=F32) * 2.0 / x.shape[-1])
    ang = pos[:, None] * inv[None, :]
    cos = jnp.cos(ang)[:, None, :]
    sin = jnp.sin(ang)[:, None, :]
    xf = x.astype(F32)
    x1, x2 = xf[..., :half], xf[..., half:]
    return jnp.concatenate([x1 * cos - x2 * sin, x1 * sin + x2 * cos], -1).astype(x.dtype)


def _linear_scan_op(left, right):
    a_l, b_l = left
    a_r, b_r = right
    return a_l * a_r, a_r * b_l + b_r


def _s5_direction(bu, a_re, a_im, log_dt, c_re, c_im, reverse):
    lam = lax.complex(a_re.astype(F32), a_im.astype(F32))
    dt = jnp.exp(log_dt.astype(F32))[:, None]
    lam_bar = jnp.exp(lam * dt)
    b_seq = bu * ((lam_bar - 1.0) / lam)
    a_seq = jnp.broadcast_to(lam_bar, b_seq.shape)
    _, h = lax.associative_scan(_linear_scan_op, (a_seq, b_seq), axis=1, reverse=reverse)
    c = lax.complex(c_re.astype(F32), c_im.astype(F32))
    return jnp.real(jnp.einsum('blgn,gpn->blgp', h, c))


def _s5_branch(u, b_re, b_im, a_re_fwd, a_im_fwd, log_dt_fwd, c_re_fwd, c_im_fwd,
               a_re_bwd, a_im_bwd, log_dt_bwd, c_re_bwd, c_im_bwd, d_skip, w_glu, b_glu):
    bsz, L, _ = u.shape
    ug = u.astype(F32).reshape(bsz, L, SSM_GROUPS, SSM_GROUP_CH)
    bu = lax.complex(jnp.einsum('blgp,gnp->blgn', ug, b_re.astype(F32)),
                     jnp.einsum('blgp,gnp->blgn', ug, b_im.astype(F32)))
    y = (_s5_direction(bu, a_re_fwd, a_im_fwd, log_dt_fwd, c_re_fwd, c_im_fwd, False)
         + _s5_direction(bu, a_re_bwd, a_im_bwd, log_dt_bwd, c_re_bwd, c_im_bwd, True)
         + d_skip.astype(F32).reshape(SSM_GROUPS, SSM_GROUP_CH) * ug)
    y = jax.nn.gelu(y.reshape(bsz, L, SSM_WIDTH)).astype(u.dtype)
    return y * jax.nn.sigmoid(y @ w_glu + b_glu)


def _mla_branch(c_q, c_kv, k_rope_in, q_norm_g, w_uq, kv_norm_g, w_ukv):
    bsz, L, _ = c_q.shape
    pos = jnp.arange(L, dtype=F32)
    q = (_rms_norm(c_q, q_norm_g) @ w_uq).reshape(bsz, L, N_HEADS, QK_NOPE + QK_ROPE)
    q_nope = q[..., :QK_NOPE]
    q_rope = _rope(q[..., QK_NOPE:], pos)
    kv = (_rms_norm(c_kv, kv_norm_g) @ w_ukv).reshape(bsz, L, N_HEADS, QK_NOPE + V_HEAD)
    k_nope = kv[..., :QK_NOPE]
    v = kv[..., QK_NOPE:]
    k_rope = _rope(k_rope_in[:, :, None, :], pos)[:, :, 0, :]
    scale = (QK_NOPE + QK_ROPE) ** -0.5
    n_blk = L // Q_BLOCK
    qn_blocks = q_nope.reshape(bsz, n_blk, Q_BLOCK, N_HEADS, QK_NOPE).transpose(1, 0, 2, 3, 4)
    qr_blocks = q_rope.reshape(bsz, n_blk, Q_BLOCK, N_HEADS, QK_ROPE).transpose(1, 0, 2, 3, 4)

    def attend(blk):
        qn_b, qr_b = blk
        s = (jnp.einsum('bqhd,bkhd->bhqk', qn_b, k_nope, preferred_element_type=F32)
             + jnp.einsum('bqhr,bkr->bhqk', qr_b, k_rope, preferred_element_type=F32))
        p = jax.nn.softmax(s * scale, axis=-1)
        return jnp.einsum('bhqk,bkhd->bqhd', p.astype(v.dtype), v)

    out = lax.map(attend, (qn_blocks, qr_blocks))
    return out.transpose(1, 0, 2, 3, 4).reshape(bsz, L, ATTN_WIDTH)


def _layer(x, w_in, ssm_b_re, ssm_b_im, ssm_a_re_fwd, ssm_a_im_fwd, ssm_log_dt_fwd,
           ssm_c_re_fwd, ssm_c_im_fwd, ssm_a_re_bwd, ssm_a_im_bwd, ssm_log_dt_bwd,
           ssm_c_re_bwd, ssm_c_im_bwd, ssm_d, w_glu, b_glu, q_norm_g, w_uq, kv_norm_g,
           w_ukv, w_branch_ssm, w_branch_attn, w_o, ln_g, ln_b):
    h = x @ w_in
    u, z_s, c_q, c_kv, k_r, z_a, g_s, g_a = jnp.split(h, IN_SPLITS, axis=-1)
    y_s = _s5_branch(u, ssm_b_re, ssm_b_im, ssm_a_re_fwd, ssm_a_im_fwd, ssm_log_dt_fwd,
                     ssm_c_re_fwd, ssm_c_im_fwd, ssm_a_re_bwd, ssm_a_im_bwd, ssm_log_dt_bwd,
                     ssm_c_re_bwd, ssm_c_im_bwd, ssm_d, w_glu, b_glu) * jax.nn.silu(z_s)
    y_a = _mla_branch(c_q, c_kv, k_r, q_norm_g, w_uq, kv_norm_g, w_ukv) * jax.nn.silu(z_a)
    merged = jax.nn.sigmoid(g_s) * (y_s @ w_branch_ssm) + jax.nn.sigmoid(g_a) * (y_a @ w_branch_attn)
    return _layer_norm(ALPHA * x + merged @ w_o, ln_g, ln_b)


def _trunk(x, ln_in_g, ln_in_b, weights):
    x = _layer_norm(x, ln_in_g, ln_in_b)
    for l in range(DEPTH):
        x = _layer(x, *[w[l] for w in weights])
    return x


def setup_inputs(seed: int = 0) -> dict:
    key = jax.random.key(seed)
    ks = jax.random.split(key, 40)

    def nrm(k, shape, scale):
        return jax.random.normal(k, shape, F32) * scale

    G, N, P = SSM_GROUPS, SSM_STATE, SSM_GROUP_CH
    n_idx = jnp.arange(N, dtype=F32)

    def a_re(k):
        return -0.5 + nrm(k, (DEPTH, G, N), 0.01)

    def a_im(k):
        return jnp.pi * n_idx + nrm(k, (DEPTH, G, N), 0.01)

    def log_dt(k):
        return jax.random.uniform(k, (DEPTH, G), F32, math.log(DT_MIN), math.log(DT_MAX))

    return {
        'x_prompt': nrm(ks[0], (BATCH, SEQ, D_MODEL), 1.0),
        'x_sample': nrm(ks[1], (DEC_BATCH, DEC_SEQ, D_MODEL), 1.0),
        'ln_in_g': 1.0 + nrm(ks[2], (D_MODEL,), 0.01),
        'ln_in_b': nrm(ks[3], (D_MODEL,), 0.01),
        'w_in': nrm(ks[4], (DEPTH, D_MODEL, IN_WIDTH), D_MODEL ** -0.5),
        'ssm_b_re': nrm(ks[5], (DEPTH, G, N, P), (2.0 * P) ** -0.5),
        'ssm_b_im': nrm(ks[6], (DEPTH, G, N, P), (2.0 * P) ** -0.5),
        'ssm_a_re_fwd': a_re(ks[7]),
        'ssm_a_im_fwd': a_im(ks[8]),
        'ssm_log_dt_fwd': log_dt(ks[9]),
        'ssm_c_re_fwd': nrm(ks[10], (DEPTH, G, P, N), (2.0 * N) ** -0.5),
        'ssm_c_im_fwd': nrm(ks[11], (DEPTH, G, P, N), (2.0 * N) ** -0.5),
        'ssm_a_re_bwd': a_re(ks[12]),
        'ssm_a_im_bwd': a_im(ks[13]),
        'ssm_log_dt_bwd': log_dt(ks[14]),
        'ssm_c_re_bwd': nrm(ks[15], (DEPTH, G, P, N), (2.0 * N) ** -0.5),
        'ssm_c_im_bwd': nrm(ks[16], (DEPTH, G, P, N), (2.0 * N) ** -0.5),
        'ssm_d': nrm(ks[17], (DEPTH, SSM_WIDTH), 1.0),
        'w_glu': nrm(ks[18], (DEPTH, SSM_WIDTH, SSM_WIDTH), SSM_WIDTH ** -0.5),
        'b_glu': nrm(ks[19], (DEPTH, SSM_WIDTH), 0.01),
        'q_norm_g': 1.0 + nrm(ks[20], (DEPTH, Q_LORA), 0.01),
        'w_uq': nrm(ks[21], (DEPTH, Q_LORA, N_HEADS * (QK_NOPE + QK_ROPE)), Q_LORA ** -0.5),
        'kv_norm_g': 1.0 + nrm(ks[22], (DEPTH, KV_LORA), 0.01),
        'w_ukv': nrm(ks[23], (DEPTH, KV_LORA, N_HEADS * (QK_NOPE + V_HEAD)), KV_LORA ** -0.5),
        'w_branch_ssm': nrm(ks[24], (DEPTH, SSM_WIDTH, D_MODEL), BETA * SSM_WIDTH ** -0.5),
        'w_branch_attn': nrm(ks[25], (DEPTH, ATTN_WIDTH, D_MODEL), BETA * ATTN_WIDTH ** -0.5),
        'w_o': nrm(ks[26], (DEPTH, D_MODEL, D_MODEL), BETA * D_MODEL ** -0.5),
        'ln_g': 1.0 + nrm(ks[27], (DEPTH, D_MODEL), 0.01),
        'ln_b': nrm(ks[28], (DEPTH, D_MODEL), 0.01),
    }


def reference(x_prompt, x_sample, ln_in_g, ln_in_b, w_in, ssm_b_re, ssm_b_im,
              ssm_a_re_fwd, ssm_a_im_fwd, ssm_log_dt_fwd, ssm_c_re_fwd, ssm_c_im_fwd,
              ssm_a_re_bwd, ssm_a_im_bwd, ssm_log_dt_bwd, ssm_c_re_bwd, ssm_c_im_bwd,
              ssm_d, w_glu, b_glu, q_norm_g, w_uq, kv_norm_g, w_ukv,
              w_branch_ssm, w_branch_attn, w_o, ln_g, ln_b):
    weights = (w_in, ssm_b_re, ssm_b_im, ssm_a_re_fwd, ssm_a_im_fwd, ssm_log_dt_fwd,
               ssm_c_re_fwd, ssm_c_im_fwd, ssm_a_re_bwd, ssm_a_im_bwd, ssm_log_dt_bwd,
               ssm_c_re_bwd, ssm_c_im_bwd, ssm_d, w_glu, b_glu, q_norm_g, w_uq, kv_norm_g,
               w_ukv, w_branch_ssm, w_branch_attn, w_o, ln_g, ln_b)
    y_prompt = _trunk(x_prompt, ln_in_g, ln_in_b, weights)
    y_sample = _trunk(x_sample, ln_in_g, ln_in_b, weights)
    return (y_prompt, y_sample)
```

```cpp
#include <hip/hip_runtime.h>
#include <hip/hip_cooperative_groups.h>
#include <cstdint>
#include <cstdio>
namespace cg = cooperative_groups;

#define DI __device__ __forceinline__
typedef unsigned short bf16_t;
typedef short bf16x8 __attribute__((ext_vector_type(8)));
typedef float f32x16 __attribute__((ext_vector_type(16)));
typedef unsigned u32x4 __attribute__((ext_vector_type(4)));
typedef unsigned u32x2 __attribute__((ext_vector_type(2)));

constexpr int MT = 65536;
constexpr int DM = 1024;
constexpr int TCH = 32;
constexpr int NCH = MT / TCH;
constexpr size_t MiB = (size_t)1 << 20;

constexpr size_t OFF_X0 = 0;
constexpr size_t OFF_S = 0;
constexpr size_t OFF_HST = 64 * MiB;
constexpr size_t OFF_U = 128 * MiB;
constexpr size_t OFF_SZS = 192 * MiB;
constexpr size_t OFF_SZA = 256 * MiB;
constexpr size_t OFF_SGS = 320 * MiB;
constexpr size_t OFF_SGA = 448 * MiB;
constexpr size_t OFF_CQ = 576 * MiB;
constexpr size_t OFF_CKV = 608 * MiB;
constexpr size_t OFF_KR = 624 * MiB;
constexpr size_t OFF_YA = 628 * MiB;
constexpr size_t OFF_W1T = 692 * MiB;
constexpr size_t OFF_WUQ = 700 * MiB;
constexpr size_t OFF_WUKV = OFF_WUQ + MiB / 2;
constexpr size_t OFF_WGLU = OFF_WUKV + MiB / 2;
constexpr size_t OFF_WBS = OFF_WGLU + MiB / 2;
constexpr size_t OFF_WBA = OFF_WBS + MiB;
constexpr size_t OFF_WO = OFF_WBA + MiB;
constexpr size_t OFF_WST = OFF_WO + 2 * MiB;
constexpr size_t OFF_WOUT = OFF_WST + 8 * MiB;
constexpr size_t OFF_LP = OFF_WOUT + 24 * MiB;
constexpr size_t OFF_BT = OFF_LP + 2 * MiB;
constexpr size_t OFF_KT = OFF_BT + MiB;
constexpr size_t OFF_ROPE = OFF_KT + 2 * MiB;
constexpr size_t OFF_STATS = OFF_ROPE + 2 * MiB;
constexpr size_t WS_NEEDED = OFF_STATS + MiB;
constexpr size_t OFF_Q = 0;
constexpr size_t OFF_K = 96 * MiB;
constexpr size_t OFF_VT = 192 * MiB;

constexpr float ALPHA_RES = 1.18920711500272f;
constexpr float QSCALE = 0.14724444f;

struct Params {
  const float *x_prompt, *x_sample, *ln_in_g, *ln_in_b, *w_in, *b_re, *b_im, *a_re_f, *a_im_f, *ldt_f, *c_re_f, *c_im_f, *a_re_b, *a_im_b,
      *ldt_b, *c_re_b, *c_im_b, *ssm_d, *w_glu, *b_glu, *q_norm_g, *w_uq, *kv_norm_g, *w_ukv, *w_bs, *w_ba, *w_o, *ln_g, *ln_b;
  float* out;
  char* ws;
  int pad0, pad1;
};

DI bf16_t f2bf(float x) { unsigned u = __float_as_uint(x); u += 0x7fffu + ((u >> 16) & 1u); return (bf16_t)(u >> 16); }
DI unsigned pk2(float lo, float hi) { unsigned r; asm("v_cvt_pk_bf16_f32 %0, %1, %2" : "=v"(r) : "v"(lo), "v"(hi)); return r; }
DI float bf2f(bf16_t b) { return __uint_as_float(((unsigned)b) << 16); }
DI float sigmoidf_(float x) { return __builtin_amdgcn_rcpf(1.f + __expf(-x)); }
DI float siluf_(float x) { return x * sigmoidf_(x); }
DI float geluf_(float x) { return x * sigmoidf_(1.5957691216057308f * (x + 0.044715f * x * x * x)); }
DI int crow(int i, int h) { return (i & 3) + 8 * (i >> 2) + 4 * h; }
DI int tok_pos(int t) { return t < 32768 ? (t & 16383) : (t & 8191); }

DI void sincos2pi(double rev, double& s, double& c) {
  rev -= rint(rev);
  double q = rint(rev * 4.0);
  double y = (rev - q * 0.25) * 6.283185307179586476925;
  double y2 = y * y;
  double sp = y * (1.0 + y2 * (-1.0 / 6 + y2 * (1.0 / 120 + y2 * (-1.0 / 5040 + y2 * (1.0 / 362880 + y2 * (-1.0 / 39916800 + y2 * (1.0 / 6227020800.0)))))));
  double cp = 1.0 + y2 * (-0.5 + y2 * (1.0 / 24 + y2 * (-1.0 / 720 + y2 * (1.0 / 40320 + y2 * (-1.0 / 3628800 + y2 * (1.0 / 479001600.0 + y2 * (-1.0 / 87178291200.0)))))));
  int qi = ((int)q) & 3;
  if (qi == 0) { s = sp; c = cp; } else if (qi == 1) { s = cp; c = -sp; } else if (qi == 2) { s = -sp; c = -cp; } else { s = -cp; c = sp; }
}

struct ARow { const bf16_t* p; int ld; DI const bf16_t* operator()(int row, int kc) const { return p + (size_t)row * ld + kc * 8; } };
struct ATwo { const bf16_t* p1; int ld1; int kc1; const bf16_t* p2; int ld2;
  DI const bf16_t* operator()(int row, int kc) const { return kc < kc1 ? p1 + (size_t)row * ld1 + kc * 8 : p2 + (size_t)row * ld2 + (kc - kc1) * 8; } };
struct AGrp { const bf16_t* p; DI const bf16_t* operator()(int row, int kc) const { return p + ((size_t)(kc >> 1) * MT + row) * 16 + (kc & 1) * 8; } };

constexpr int STL = 132;
constexpr int OFF_RSS = 128 * STL * 4;
DI int swz(int row, int c) { return row * 128 + ((c ^ ((row >> 1) & 7)) << 4); }

template <class AL, bool ROWSS>
DI void gemm_main(f32x16 (&acc)[2][2], const AL& al, int m0, const bf16_t* __restrict__ Bt, int ldb, int n0, int K, char* smem) {
  const int tid = threadIdx.x, lane = tid & 63, wave = tid >> 6, wm = wave >> 1, wn = wave & 1, r = lane & 31, h = lane >> 5;
  const int srow = tid >> 3, sch = tid & 7;
  u32x4 ra[4], rb[4];
  float ss[4] = {0.f, 0.f, 0.f, 0.f};
  const int nk = K >> 6;
#pragma unroll
  for (int mi = 0; mi < 2; ++mi)
#pragma unroll
    for (int ni = 0; ni < 2; ++ni)
#pragma unroll
      for (int i = 0; i < 16; ++i) acc[mi][ni][i] = 0.f;
#pragma unroll
  for (int i = 0; i < 4; ++i) {
    ra[i] = *(const u32x4*)al(m0 + srow + 32 * i, sch);
    rb[i] = *(const u32x4*)(Bt + (size_t)(n0 + srow + 32 * i) * ldb + sch * 8);
  }
  for (int kt = 0; kt < nk; ++kt) {
    char* sa = smem + (kt & 1) * 32768;
    char* sb = sa + 16384;
#pragma unroll
    for (int i = 0; i < 4; ++i) {
      const int off = swz(srow + 32 * i, sch);
      *(u32x4*)(sa + off) = ra[i];
      *(u32x4*)(sb + off) = rb[i];
      if (ROWSS) {
#pragma unroll
        for (int j = 0; j < 4; ++j) { float lo = __uint_as_float(ra[i][j] << 16), hi = __uint_as_float(ra[i][j] & 0xffff0000u); ss[i] += lo * lo + hi * hi; }
      }
    }
    __syncthreads();
    if (kt + 1 < nk) {
#pragma unroll
      for (int i = 0; i < 4; ++i) {
        ra[i] = *(const u32x4*)al(m0 + srow + 32 * i, (kt + 1) * 8 + sch);
        rb[i] = *(const u32x4*)(Bt + (size_t)(n0 + srow + 32 * i) * ldb + (kt + 1) * 64 + sch * 8);
      }
    }
#pragma unroll
    for (int ks = 0; ks < 4; ++ks) {
      bf16x8 af[2], bfr[2];
#pragma unroll
      for (int mi = 0; mi < 2; ++mi) af[mi] = *(const bf16x8*)(sa + swz(wm * 64 + mi * 32 + r, ks * 2 + h));
#pragma unroll
      for (int ni = 0; ni < 2; ++ni) bfr[ni] = *(const bf16x8*)(sb + swz(wn * 64 + ni * 32 + r, ks * 2 + h));
#pragma unroll
      for (int mi = 0; mi < 2; ++mi)
#pragma unroll
        for (int ni = 0; ni < 2; ++ni) acc[mi][ni] = __builtin_amdgcn_mfma_f32_32x32x16_bf16(af[mi], bfr[ni], acc[mi][ni], 0, 0, 0);
    }
  }
  __syncthreads();
  if (ROWSS) {
    float* rss = (float*)(smem + OFF_RSS);
#pragma unroll
    for (int i = 0; i < 4; ++i) {
      float v = ss[i];
      v += __shfl_xor(v, 1); v += __shfl_xor(v, 2); v += __shfl_xor(v, 4);
      if (sch == 0) rss[srow + 32 * i] = v;
    }
    __syncthreads();
  }
}

DI void stage_acc(const f32x16 (&acc)[2][2], float* st) {
  const int lane = threadIdx.x & 63, wave = threadIdx.x >> 6, wm = wave >> 1, wn = wave & 1, r = lane & 31, h = lane >> 5;
#pragma unroll
  for (int mi = 0; mi < 2; ++mi)
#pragma unroll
    for (int ni = 0; ni < 2; ++ni)
#pragma unroll
      for (int i = 0; i < 16; ++i) st[(wm * 64 + mi * 32 + crow(i, h)) * STL + wn * 64 + ni * 32 + r] = acc[mi][ni][i];
  __syncthreads();
}
DI void ld8(const float* st, float (&v)[8]) { const float4 a = *(const float4*)st, b = *(const float4*)(st + 4); v[0] = a.x; v[1] = a.y; v[2] = a.z; v[3] = a.w; v[4] = b.x; v[5] = b.y; v[6] = b.z; v[7] = b.w; }
DI void ld8bf(const bf16_t* p, float (&v)[8]) {
  const u32x4 w = *(const u32x4*)p;
#pragma unroll
  for (int j = 0; j < 4; ++j) { v[2 * j] = __uint_as_float(w[j] << 16); v[2 * j + 1] = __uint_as_float(w[j] & 0xffff0000u); }
}
DI void st8bf(bf16_t* p, const float (&v)[8]) { u32x4 w; w.x = pk2(v[0], v[1]); w.y = pk2(v[2], v[3]); w.z = pk2(v[4], v[5]); w.w = pk2(v[6], v[7]); *(u32x4*)p = w; }
#define EPI8_BEGIN(st, NIT, CSH)                                              \
  _Pragma("unroll 1") for (int it_ = 0; it_ < (NIT); ++it_) {                   \
    const int gid_ = it_ * 256 + threadIdx.x; const int lrow = gid_ >> (CSH), lc0 = (gid_ & ((1 << (CSH)) - 1)) * 8; \
    float v[8]; ld8((st) + lrow * STL + lc0, v);
#define EPI8_END } __syncthreads();

DI void ph_tables(const Params& P) {
  const int gt = blockIdx.x * blockDim.x + threadIdx.x, gs = gridDim.x * blockDim.x;
  float2* LP = (float2*)(P.ws + OFF_LP);
  float2* BT = (float2*)(P.ws + OFF_BT);
  float2* ROPE = (float2*)(P.ws + OFF_ROPE);
  for (int idx = gt; idx < 32 * 2 * 64; idx += gs) {
    const int n = idx & 63, dir = (idx >> 6) & 1, g = idx >> 7;
    const double are = dir ? (double)P.a_re_b[g * 64 + n] : (double)P.a_re_f[g * 64 + n];
    const double aim = dir ? (double)P.a_im_b[g * 64 + n] : (double)P.a_im_f[g * 64 + n];
    const double dt = exp(dir ? (double)P.ldt_b[g] : (double)P.ldt_f[g]);
    double l1r = 1.0, l1i = 0.0;
    for (int d = 0; d <= 32; ++d) {
      const double mag = exp(are * dt * d);
      double s, c; sincos2pi(aim * dt * d * 0.15915494309189533577, s, c);
      LP[((g * 2 + dir) * 33 + d) * 64 + n] = make_float2((float)(mag * c), (float)(mag * s));
      if (d == 1) { l1r = mag * c; l1i = mag * s; }
    }
    const double zr = are * dt, zi = aim * dt;
    double cr, ci;
    if (zr * zr + zi * zi < 0.25) {
      double tr = 1.0, ti = 0.0, sr = 1.0, si = 0.0;
      for (int k = 1; k < 24; ++k) { const double nr = (tr * zr - ti * zi) / (k + 1), ni = (tr * zi + ti * zr) / (k + 1); tr = nr; ti = ni; sr += tr; si += ti; }
      cr = sr * dt; ci = si * dt;
    } else {
      const double nr = l1r - 1.0, ni = l1i, den = are * are + aim * aim;
      cr = (nr * are + ni * aim) / den; ci = (ni * are - nr * aim) / den;
    }
    for (int q = 0; q < 16; ++q) {
      const double br = P.b_re[(g * 64 + n) * 16 + q], bi = P.b_im[(g * 64 + n) * 16 + q];
      BT[((g * 2 + dir) * 64 + n) * 16 + q] = make_float2((float)(br * cr - bi * ci), (float)(br * ci + bi * cr));
    }
  }
  for (int idx = gt; idx < 16384 * 16; idx += gs) {
    const int j = idx & 15, pos = idx >> 4;
    const double inv = exp(-(double)j * (9.210340371976182736 / 16.0));
    double s, c; sincos2pi((double)pos * inv * 0.15915494309189533577, s, c);
    ROPE[idx] = make_float2((float)c, (float)s);
  }
}

DI void transpose_tile(const float* __restrict__ src, int lds_, int K, bf16_t* __restrict__ dst, int k0, int n0, int mode, const float* __restrict__ rowscale, float* tile) {
  const int tid = threadIdx.x;
  {
    const int nn = tid & 63, n = n0 + nn;
    int sc = n;
    if (mode == 1) sc = n < 1440 ? n : (n < 1536 ? -1 : n - 96);
#pragma unroll 4
    for (int i = 0; i < 16; ++i) {
      const int kk = (tid >> 6) + 4 * i, k = k0 + kk;
      float v = sc >= 0 ? src[(size_t)k * lds_ + sc] : 0.f;
      if (rowscale) v *= rowscale[k];
      tile[kk * 65 + nn] = v;
    }
  }
  __syncthreads();
  {
    const int kk = tid & 63;
#pragma unroll 4
    for (int i = 0; i < 16; ++i) { const int nn = (tid >> 6) + 4 * i; dst[(size_t)(n0 + nn) * K + k0 + kk] = f2bf(tile[kk * 65 + nn]); }
  }
  __syncthreads();
}

DI void ph_prep(const Params& P, char* smem) {
  const int gt = blockIdx.x * blockDim.x + threadIdx.x, gs = gridDim.x * blockDim.x;
  const float2* LP = (const float2*)(P.ws + OFF_LP);
  const float2* BT = (const float2*)(P.ws + OFF_BT);
  float* KT = (float*)(P.ws + OFF_KT);
  bf16_t* WST = (bf16_t*)(P.ws + OFF_WST);
  bf16_t* WOUT = (bf16_t*)(P.ws + OFF_WOUT);
  for (int idx = gt; idx < 32 * 2 * 32 * 256; idx += gs) {
    const int q = idx & 15, p = (idx >> 4) & 15, d = (idx >> 8) & 31, dir = (idx >> 13) & 1, g = idx >> 14;
    const float* cre = (dir ? P.c_re_b : P.c_re_f) + (g * 16 + p) * 64;
    const float* cim = (dir ? P.c_im_b : P.c_im_f) + (g * 16 + p) * 64;
    const float2* lp = LP + ((g * 2 + dir) * 33 + d) * 64;
    const float2* bt = BT + ((g * 2 + dir) * 64) * 16 + q;
    float s = 0.f;
    for (int n = 0; n < 64; ++n) {
      const float2 l = lp[n], b = bt[n * 16];
      const float wr = l.x * b.x - l.y * b.y, wi = l.x * b.y + l.y * b.x;
      s += cre[n] * wr - cim[n] * wi;
    }
    KT[idx] = s;
  }
  for (int idx = gt; idx < 32 * 256 * 512; idx += gs) {
    const int k = idx & 511, np = (idx >> 9) & 255, g = idx >> 17;
    const int q = k & 15, s = k >> 4, n = np & 63, reim = (np >> 6) & 1, dir = np >> 7;
    const int e = dir ? s : (TCH - 1 - s);
    const float2 l = LP[((g * 2 + dir) * 33 + e) * 64 + n], b = BT[((g * 2 + dir) * 64 + n) * 16 + q];
    const float val = reim ? (l.x * b.y + l.y * b.x) : (l.x * b.x - l.y * b.y);
    WST[idx] = f2bf(val);
  }
  for (int idx = gt; idx < 32 * 512 * 256; idx += gs) {
    const int k2 = idx & 255, tp = (idx >> 8) & 511, g = idx >> 17;
    const int n = k2 & 63, reim = (k2 >> 6) & 1, dir = k2 >> 7, p = tp & 15, t = tp >> 4;
    const int e = dir ? (TCH - t) : (t + 1);
    const float2 l = LP[((g * 2 + dir) * 33 + e) * 64 + n];
    const float cr = (dir ? P.c_re_b : P.c_re_f)[(g * 16 + p) * 64 + n], ci = (dir ? P.c_im_b : P.c_im_f)[(g * 16 + p) * 64 + n];
    const float val = reim ? -(cr * l.y + ci * l.x) : (cr * l.x - ci * l.y);
#ifdef PROBE_NO_CONV
    WOUT[((size_t)g * 512 + tp) * 768 + 512 + k2] = 0;
#else
    WOUT[((size_t)g * 512 + tp) * 768 + 512 + k2] = f2bf(val);
#endif
  }
  {
    float* tile = (float*)smem;
    for (int u = blockIdx.x; u < 1680; u += gridDim.x) {
      if (u < 1024) transpose_tile(P.w_in, 4000, 1024, (bf16_t*)(P.ws + OFF_W1T), (u & 15) * 64, (u >> 4) * 64, 1, nullptr, tile);
      else if (u < 1072) { const int v = u - 1024; transpose_tile(P.w_uq, 768, 256, (bf16_t*)(P.ws + OFF_WUQ), (v & 3) * 64, (v >> 2) * 64, 0, P.q_norm_g, tile); }
      else if (u < 1104) { const int v = u - 1072; transpose_tile(P.w_ukv, 1024, 128, (bf16_t*)(P.ws + OFF_WUKV), (v & 1) * 64, (v >> 1) * 64, 0, P.kv_norm_g, tile); }
      else if (u < 1168) { const int v = u - 1104; transpose_tile(P.w_glu, 512, 512, (bf16_t*)(P.ws + OFF_WGLU), (v & 7) * 64, (v >> 3) * 64, 0, nullptr, tile); }
      else if (u < 1296) { const int v = u - 1168; transpose_tile(P.w_bs, 1024, 512, (bf16_t*)(P.ws + OFF_WBS), (v & 7) * 64, (v >> 3) * 64, 0, nullptr, tile); }
      else if (u < 1424) { const int v = u - 1296; transpose_tile(P.w_ba, 1024, 512, (bf16_t*)(P.ws + OFF_WBA), (v & 7) * 64, (v >> 3) * 64, 0, nullptr, tile); }
      else { const int v = u - 1424; transpose_tile(P.w_o, 1024, 1024, (bf16_t*)(P.ws + OFF_WO), (v & 15) * 64, (v >> 4) * 64, 0, nullptr, tile); }
    }
  }
  {
    bf16_t* X0 = (bf16_t*)(P.ws + OFF_X0);
    float2* STATS = (float2*)(P.ws + OFF_STATS);
    const int lane = threadIdx.x & 63, gw = gt >> 6, nw = gs >> 6;
    for (int row = gw; row < MT; row += nw) {
      const float* xr = row < 32768 ? P.x_prompt + (size_t)row * DM : P.x_sample + (size_t)(row - 32768) * DM;
      float4 v[4];
      float s = 0.f;
#pragma unroll
      for (int i = 0; i < 4; ++i) { v[i] = *(const float4*)(xr + i * 256 + lane * 4); s += (v[i].x + v[i].y) + (v[i].z + v[i].w); }
#pragma unroll
      for (int o = 32; o >= 1; o >>= 1) s += __shfl_xor(s, o);
      const float mu = s * (1.f / 1024.f);
      float q = 0.f;
#pragma unroll
      for (int i = 0; i < 4; ++i) { const float a = v[i].x - mu, b = v[i].y - mu, c = v[i].z - mu, d = v[i].w - mu; q += (a * a + b * b) + (c * c + d * d); }
#pragma unroll
      for (int o = 32; o >= 1; o >>= 1) q += __shfl_xor(q, o);
      const float rstd = rsqrtf(q * (1.f / 1024.f) + 1e-5f);
      if (lane == 0) STATS[row] = make_float2(mu, rstd);
#pragma unroll
      for (int i = 0; i < 4; ++i) {
        const int c = i * 256 + lane * 4;
        const float4 g = *(const float4*)(P.ln_in_g + c), b = *(const float4*)(P.ln_in_b + c);
        u32x2 o;
        o.x = pk2((v[i].x - mu) * rstd * g.x + b.x, (v[i].y - mu) * rstd * g.y + b.y);
        o.y = pk2((v[i].z - mu) * rstd * g.z + b.z, (v[i].w - mu) * rstd * g.w + b.w);
        *(u32x2*)(X0 + (size_t)row * DM + c) = o;
      }
    }
  }
}

DI void ph_g1(const Params& P, char* smem) {
  const int gt = blockIdx.x * blockDim.x + threadIdx.x, gs = gridDim.x * blockDim.x;
  {
    const float* KT = (const float*)(P.ws + OFF_KT);
    bf16_t* WOUT = (bf16_t*)(P.ws + OFF_WOUT);
    for (int idx = gt; idx < 32 * 512 * 512; idx += gs) {
      const int k = idx & 511, tp = (idx >> 9) & 511, g = idx >> 18;
      const int q = k & 15, s = k >> 4, p = tp & 15, t = tp >> 4;
      float val;
      if (s < t) val = KT[(((g * 2 + 0) * 32 + (t - s)) * 16 + p) * 16 + q];
      else if (s > t) val = KT[(((g * 2 + 1) * 32 + (s - t)) * 16 + p) * 16 + q];
      else val = KT[(((g * 2 + 0) * 32) * 16 + p) * 16 + q] + KT[(((g * 2 + 1) * 32) * 16 + p) * 16 + q] + (p == q ? P.ssm_d[g * 16 + p] : 0.f);
#ifdef PROBE_NO_CONV
      val = (s == t && p == q) ? P.ssm_d[g * 16 + p] : 0.f;
#endif
      WOUT[((size_t)g * 512 + tp) * 768 + k] = f2bf(val);
    }
  }
  const bf16_t* X0 = (const bf16_t*)(P.ws + OFF_X0);
  const bf16_t* W1T = (const bf16_t*)(P.ws + OFF_W1T);
  bf16_t* U = (bf16_t*)(P.ws + OFF_U);
  bf16_t* SZS = (bf16_t*)(P.ws + OFF_SZS);
  bf16_t* SZA = (bf16_t*)(P.ws + OFF_SZA);
  bf16_t* SGS = (bf16_t*)(P.ws + OFF_SGS);
  bf16_t* SGA = (bf16_t*)(P.ws + OFF_SGA);
  bf16_t* CQ = (bf16_t*)(P.ws + OFF_CQ);
  bf16_t* CKV = (bf16_t*)(P.ws + OFF_CKV);
  bf16_t* KR = (bf16_t*)(P.ws + OFF_KR);
  const float2* ROPE = (const float2*)(P.ws + OFF_ROPE);
  for (int tile = blockIdx.x; tile < 512 * 32; tile += gridDim.x) {
    const int nt = tile & 31, mt = tile >> 5, m0 = mt * 128, n0 = nt * 128;
    f32x16 acc[2][2];
    gemm_main<ARow, false>(acc, ARow{X0, 1024}, m0, W1T, 1024, n0, 1024, smem);
    float* st = (float*)smem;
    stage_acc(acc, st);
    if (nt < 4) {
      EPI8_BEGIN(st, 8, 4) const int col = n0 + lc0; st8bf(U + ((size_t)(col >> 4) * MT + m0 + lrow) * 16 + (col & 15), v); EPI8_END
    } else if (nt < 8) {
      EPI8_BEGIN(st, 8, 4)
#pragma unroll
        for (int j = 0; j < 8; ++j) v[j] = siluf_(v[j]);
        st8bf(SZS + (size_t)(m0 + lrow) * 512 + n0 - 512 + lc0, v);
      EPI8_END
    } else if (nt < 10) {
      EPI8_BEGIN(st, 8, 4) st8bf(CQ + (size_t)(m0 + lrow) * 256 + n0 - 1024 + lc0, v); EPI8_END
    } else if (nt == 10) {
      EPI8_BEGIN(st, 8, 4) st8bf(CKV + (size_t)(m0 + lrow) * 128 + lc0, v); EPI8_END
    } else if (nt == 11) {
      EPI8_BEGIN(st, 8, 4)
        if (lc0 < 32) {
          const int tok = m0 + lrow; const float2* cs = ROPE + tok_pos(tok) * 16 + (lc0 & 15);
          float pv[8]; ld8(st + lrow * STL + (lc0 ^ 16), pv);
          float o[8];
#pragma unroll
          for (int j = 0; j < 8; ++j) o[j] = lc0 < 16 ? v[j] * cs[j].x - pv[j] * cs[j].y : pv[j] * cs[j].y + v[j] * cs[j].x;
          st8bf(KR + (size_t)tok * 32 + lc0, o);
        }
      EPI8_END
    } else if (nt < 16) {
      EPI8_BEGIN(st, 8, 4)
#pragma unroll
        for (int j = 0; j < 8; ++j) v[j] = siluf_(v[j]);
        st8bf(SZA + (size_t)(m0 + lrow) * 512 + n0 - 1536 + lc0, v);
      EPI8_END
    } else if (nt < 24) {
      EPI8_BEGIN(st, 8, 4)
#pragma unroll
        for (int j = 0; j < 8; ++j) v[j] = sigmoidf_(v[j]);
        st8bf(SGS + (size_t)(m0 + lrow) * 1024 + n0 - 2048 + lc0, v);
      EPI8_END
    } else {
      EPI8_BEGIN(st, 8, 4)
#pragma unroll
        for (int j = 0; j < 8; ++j) v[j] = sigmoidf_(v[j]);
        st8bf(SGA + (size_t)(m0 + lrow) * 1024 + n0 - 3072 + lc0, v);
      EPI8_END
    }
  }
}

DI void ph_qkv(const Params& P, char* smem) {
  const bf16_t* CQ = (const bf16_t*)(P.ws + OFF_CQ);
  const bf16_t* CKV = (const bf16_t*)(P.ws + OFF_CKV);
  const bf16_t* KR = (const bf16_t*)(P.ws + OFF_KR);
  const bf16_t* U = (const bf16_t*)(P.ws + OFF_U);
  const float2* ROPE = (const float2*)(P.ws + OFF_ROPE);
  bf16_t* Q = (bf16_t*)((char*)P.out + OFF_Q);
  bf16_t* KM = (bf16_t*)((char*)P.out + OFF_K);
  bf16_t* VT = (bf16_t*)((char*)P.out + OFF_VT);
  float* S = (float*)(P.ws + OFF_S);
  const float* rss = (const float*)(smem + OFF_RSS);
  float* st = (float*)smem;
  const int NU = 3072 + 4096 + 1024;
  for (int u = blockIdx.x; u < NU; u += gridDim.x) {
    f32x16 acc[2][2];
    if (u < 3072) {
      const int nt = u % 6, mt = u / 6, m0 = mt * 128, n0 = nt * 128;
      gemm_main<ARow, true>(acc, ARow{CQ, 256}, m0, (const bf16_t*)(P.ws + OFF_WUQ), 256, n0, 256, smem);
      stage_acc(acc, st);
      EPI8_BEGIN(st, 8, 4)
        const int col = n0 + lc0, head = col / 96, c = col - head * 96, tok = m0 + lrow;
        const float sc = rsqrtf(rss[lrow] * (1.f / 256.f) + 1e-6f) * QSCALE;
        float o[8];
        if (c >= 64) {
          const float2* cs = ROPE + tok_pos(tok) * 16 + (c & 15);
          float pv[8]; ld8(st + lrow * STL + (lc0 ^ 16), pv);
#pragma unroll
          for (int j = 0; j < 8; ++j) o[j] = ((c & 16) ? pv[j] * cs[j].y + v[j] * cs[j].x : v[j] * cs[j].x - pv[j] * cs[j].y) * sc;
        } else {
#pragma unroll
          for (int j = 0; j < 8; ++j) o[j] = v[j] * sc;
        }
        st8bf(Q + ((size_t)head * MT + tok) * 96 + c, o);
      EPI8_END
    } else if (u < 3072 + 4096) {
      const int v2 = u - 3072, head = v2 & 7, mt = v2 >> 3, m0 = mt * 128, n0 = head * 128;
      gemm_main<ARow, true>(acc, ARow{CKV, 128}, m0, (const bf16_t*)(P.ws + OFF_WUKV), 128, n0, 128, smem);
      stage_acc(acc, st);
#pragma unroll 1
      for (int it = 0; it < 4; ++it) {
        const int gid = it * 256 + threadIdx.x, lrow = gid >> 3, lc0 = (gid & 7) * 8, tok = m0 + lrow;
        const float sc = rsqrtf(rss[lrow] * (1.f / 128.f) + 1e-6f);
        float v[8]; ld8(st + lrow * STL + lc0, v);
#pragma unroll
        for (int j = 0; j < 8; ++j) v[j] *= sc;
        st8bf(KM + ((size_t)head * MT + tok) * 96 + lc0, v);
      }
#pragma unroll 1
      for (int it = 0; it < 4; ++it) {
        const int gid = it * 256 + threadIdx.x, dv = gid >> 4, rg = (gid & 15) * 8;
        float v[8];
#pragma unroll
        for (int j = 0; j < 8; ++j) v[j] = st[(rg + j) * STL + 64 + dv] * rsqrtf(rss[rg + j] * (1.f / 128.f) + 1e-6f);
        st8bf(VT + ((size_t)head * 64 + dv) * MT + m0 + rg, v);
      }
      {
        const int tok = m0 + (threadIdx.x >> 1), hf = threadIdx.x & 1;
        const u32x4* sp = (const u32x4*)(KR + (size_t)tok * 32 + hf * 16);
        u32x4* d = (u32x4*)(KM + ((size_t)head * MT + tok) * 96 + 64 + hf * 16);
        d[0] = sp[0]; d[1] = sp[1];
      }
      __syncthreads();
    } else {
      const int v2 = u - 7168, nt = v2 & 1, mt = (v2 >> 1) & 15, g = v2 >> 5, m0 = mt * 128, n0 = nt * 128;
      gemm_main<ARow, false>(acc, ARow{U + (size_t)g * MT * 16, 512}, m0, (const bf16_t*)(P.ws + OFF_WST) + (size_t)g * 256 * 512, 512, n0, 512, smem);
      stage_acc(acc, st);
      EPI8_BEGIN(st, 8, 4)
        float* d = S + ((size_t)g * NCH + m0 + lrow) * 256 + n0 + lc0;
        *(float4*)d = make_float4(v[0], v[1], v[2], v[3]); *(float4*)(d + 4) = make_float4(v[4], v[5], v[6], v[7]);
      EPI8_END
    }
  }
}

DI void ph_scan(const Params& P) {
  const int gt = blockIdx.x * blockDim.x + threadIdx.x, gs = gridDim.x * blockDim.x;
  const float* S = (const float*)(P.ws + OFF_S);
  bf16_t* HST = (bf16_t*)(P.ws + OFF_HST);
  const float2* LP = (const float2*)(P.ws + OFF_LP);
  for (int idx = gt; idx < 6 * 32 * 2 * 64; idx += gs) {
    const int n = idx & 63, dir = (idx >> 6) & 1, g = (idx >> 7) & 31, seq = idx >> 12;
    const int c0 = seq < 2 ? seq * 512 : 1024 + (seq - 2) * 256, nc = seq < 2 ? 512 : 256;
    const float2 a = LP[((g * 2 + dir) * 33 + 32) * 64 + n];
    float hr = 0.f, hi = 0.f;
    const float* Sg = S + (size_t)g * NCH * 256 + dir * 128 + n;
    bf16_t* Hg = HST + (size_t)g * NCH * 256 + dir * 128 + n;
    for (int cb = 0; cb < nc; cb += 8) {
      float sr[8], si[8];
#pragma unroll
      for (int j = 0; j < 8; ++j) { const int c = dir ? (c0 + nc - 1 - cb - j) : (c0 + cb + j); sr[j] = Sg[(size_t)c * 256]; si[j] = Sg[(size_t)c * 256 + 64]; }
#pragma unroll
      for (int j = 0; j < 8; ++j) {
        const int c = dir ? (c0 + nc - 1 - cb - j) : (c0 + cb + j);
        Hg[(size_t)c * 256] = f2bf(hr); Hg[(size_t)c * 256 + 64] = f2bf(hi);
        const float nr = a.x * hr - a.y * hi + sr[j], ni = a.x * hi + a.y * hr + si[j];
        hr = nr; hi = ni;
      }
    }
  }
}

DI void attn_unit(const Params& P, int tok0, int L, int head, int q0, char* smem) {
  const int tid = threadIdx.x, lane = tid & 63, wave = tid >> 6, r = lane & 31, h = lane >> 5;
  const bf16_t* Qh = (const bf16_t*)((char*)P.out + OFF_Q) + (size_t)head * MT * 96;
  const bf16_t* Kh = (const bf16_t*)((char*)P.out + OFF_K) + ((size_t)head * MT + tok0) * 96;
  const bf16_t* Vh = (const bf16_t*)((char*)P.out + OFF_VT) + (size_t)head * 64 * MT + tok0;
  const bf16_t* SZA = (const bf16_t*)(P.ws + OFF_SZA);
  bf16_t* YA = (bf16_t*)(P.ws + OFF_YA);
  const int qtok = tok0 + q0 + wave * 32 + r;
  bf16x8 qf[6];
#pragma unroll
  for (int ks = 0; ks < 6; ++ks) qf[ks] = *(const bf16x8*)(Qh + (size_t)qtok * 96 + ks * 16 + h * 8);
  f32x16 O[2];
#pragma unroll
  for (int i = 0; i < 16; ++i) { O[0][i] = 0.f; O[1][i] = 0.f; }
  float m = -INFINITY, l = 0.f;
  u32x4 rk[3], rv[2];
  int krow_[3], kch_[3];
#pragma unroll
  for (int i = 0; i < 3; ++i) { const int id = tid + 256 * i; krow_[i] = id / 12; kch_[i] = id - krow_[i] * 12; }
  const int vrow = tid >> 3, vch = tid & 7;
  const int nkt = L >> 6;
#pragma unroll
  for (int i = 0; i < 3; ++i) rk[i] = *(const u32x4*)(Kh + (size_t)krow_[i] * 96 + kch_[i] * 8);
#pragma unroll
  for (int i = 0; i < 2; ++i) rv[i] = *(const u32x4*)(Vh + (size_t)(vrow + 32 * i) * MT + vch * 8);
  for (int kt = 0; kt < nkt; ++kt) {
    char* sk = smem + (kt & 1) * 22016;
    char* sv = sk + 13312;
#pragma unroll
    for (int i = 0; i < 3; ++i) *(u32x4*)(sk + krow_[i] * 208 + kch_[i] * 16) = rk[i];
#pragma unroll
    for (int i = 0; i < 2; ++i) {
      char* d = sv + (vrow + 32 * i) * 136 + vch * 16;
      *(u32x2*)d = (u32x2){rv[i].x, rv[i].y};
      *(u32x2*)(d + 8) = (u32x2){rv[i].z, rv[i].w};
    }
    __syncthreads();
    if (kt + 1 < nkt) {
      const int key0 = (kt + 1) * 64;
#pragma unroll
      for (int i = 0; i < 3; ++i) rk[i] = *(const u32x4*)(Kh + (size_t)(key0 + krow_[i]) * 96 + kch_[i] * 8);
#pragma unroll
      for (int i = 0; i < 2; ++i) rv[i] = *(const u32x4*)(Vh + (size_t)(vrow + 32 * i) * MT + key0 + vch * 8);
    }
    f32x16 S[2];
#pragma unroll
    for (int kb = 0; kb < 2; ++kb) {
#pragma unroll
      for (int i = 0; i < 16; ++i) S[kb][i] = 0.f;
#pragma unroll
      for (int ks = 0; ks < 6; ++ks) {
        const bf16x8 kf = *(const bf16x8*)(sk + (kb * 32 + r) * 208 + (ks * 2 + h) * 16);
        S[kb] = __builtin_amdgcn_mfma_f32_32x32x16_bf16(kf, qf[ks], S[kb], 0, 0, 0);
      }
    }
    float mx = S[0][0];
#pragma unroll
    for (int i = 1; i < 16; ++i) mx = fmaxf(mx, S[0][i]);
#pragma unroll
    for (int i = 0; i < 16; ++i) mx = fmaxf(mx, S[1][i]);
    mx = fmaxf(mx, __shfl_xor(mx, 32));
    const float mn = fmaxf(m, mx);
    const float alpha = __builtin_amdgcn_exp2f(m - mn);
    m = mn;
    float ps = 0.f;
#pragma unroll
    for (int kb = 0; kb < 2; ++kb)
#pragma unroll
      for (int i = 0; i < 16; ++i) { S[kb][i] = __builtin_amdgcn_exp2f(S[kb][i] - mn); ps += S[kb][i]; }
    l = l * alpha + ps;
#pragma unroll
    for (int i = 0; i < 16; ++i) { O[0][i] *= alpha; O[1][i] *= alpha; }
    bf16x8 pf[2][2];
#pragma unroll
    for (int kb = 0; kb < 2; ++kb)
#pragma unroll
      for (int s = 0; s < 2; ++s) {
        u32x4 w;
        w.x = pk2(S[kb][8 * s + 0], S[kb][8 * s + 1]); w.y = pk2(S[kb][8 * s + 2], S[kb][8 * s + 3]);
        w.z = pk2(S[kb][8 * s + 4], S[kb][8 * s + 5]); w.w = pk2(S[kb][8 * s + 6], S[kb][8 * s + 7]);
        pf[kb][s] = __builtin_bit_cast(bf16x8, w);
      }
#pragma unroll
    for (int db = 0; db < 2; ++db)
#pragma unroll
      for (int kb = 0; kb < 2; ++kb)
#pragma unroll
        for (int s = 0; s < 2; ++s) {
          const char* a = sv + (db * 32 + r) * 136 + (kb * 32 + s * 16 + h * 4) * 2;
          const u32x2 lo = *(const u32x2*)a, hi = *(const u32x2*)(a + 16);
          const u32x4 w = {lo.x, lo.y, hi.x, hi.y};
          O[db] = __builtin_amdgcn_mfma_f32_32x32x16_bf16(__builtin_bit_cast(bf16x8, w), pf[kb][s], O[db], 0, 0, 0);
        }
  }
  __syncthreads();
  l += __shfl_xor(l, 32);
  const float inv = 1.f / l;
#pragma unroll
  for (int db = 0; db < 2; ++db)
#pragma unroll
    for (int g4 = 0; g4 < 4; ++g4) {
      const size_t o = (size_t)qtok * 512 + head * 64 + db * 32 + 8 * g4 + 4 * h;
      const u32x2 gz = *(const u32x2*)(SZA + o);
      const float g0 = __uint_as_float(gz.x << 16), g1 = __uint_as_float(gz.x & 0xffff0000u), g2 = __uint_as_float(gz.y << 16), g3 = __uint_as_float(gz.y & 0xffff0000u);
      u32x2 w;
      w.x = pk2(O[db][4 * g4 + 0] * inv * g0, O[db][4 * g4 + 1] * inv * g1);
      w.y = pk2(O[db][4 * g4 + 2] * inv * g2, O[db][4 * g4 + 3] * inv * g3);
#ifdef PROBE_NO_ATTN
      w.x = 0; w.y = 0;
#endif
      *(u32x2*)(YA + o) = w;
    }
}

DI void ph_mix(const Params& P, char* smem) {
  const bf16_t* U = (const bf16_t*)(P.ws + OFF_U);
  const bf16_t* HST = (const bf16_t*)(P.ws + OFF_HST);
  bf16_t* Y = (bf16_t*)(P.ws + OFF_S);
  const int NU = 2048 + 4096;
  for (int u = blockIdx.x; u < NU; u += gridDim.x) {
    if (u < 2048) {
      const int nt = u & 3, mt = (u >> 2) & 15, g = u >> 6, m0 = mt * 128, n0 = nt * 128;
      f32x16 acc[2][2];
      gemm_main<ATwo, false>(acc, ATwo{U + (size_t)g * MT * 16, 512, 64, HST + (size_t)g * NCH * 256, 256}, m0,
                             (const bf16_t*)(P.ws + OFF_WOUT) + (size_t)g * 512 * 768, 768, n0, 768, smem);
      float* st = (float*)smem;
      stage_acc(acc, st);
      EPI8_BEGIN(st, 8, 4)
#pragma unroll
        for (int j = 0; j < 8; ++j) v[j] = geluf_(v[j]);
        st8bf(Y + ((size_t)g * NCH + m0 + lrow) * 512 + n0 + lc0, v);
      EPI8_END
    } else {
      const int v2 = u - 2048;
      const int head = v2 & 7, w = v2 >> 3;
      int tok0, L, qb;
      if (w < 256) { const int seq = w >> 7; qb = w & 127; tok0 = seq * 16384; L = 16384; }
      else { const int w2 = w - 256; const int seq = w2 >> 6; qb = w2 & 63; tok0 = 32768 + seq * 8192; L = 8192; }
      attn_unit(P, tok0, L, head, qb * 128, smem);
    }
  }
}

DI void ph_glu(const Params& P, char* smem) {
  const bf16_t* Y = (const bf16_t*)(P.ws + OFF_S);
  const bf16_t* SZS = (const bf16_t*)(P.ws + OFF_SZS);
  bf16_t* YS = (bf16_t*)(P.ws + OFF_U);
  for (int u = blockIdx.x; u < 2048; u += gridDim.x) {
    const int nt = u & 3, mt = u >> 2, m0 = mt * 128, n0 = nt * 128;
    f32x16 acc[2][2];
    gemm_main<AGrp, false>(acc, AGrp{Y}, m0, (const bf16_t*)(P.ws + OFF_WGLU), 512, n0, 512, smem);
    float* st = (float*)smem;
    stage_acc(acc, st);
    EPI8_BEGIN(st, 8, 4)
      const int col = n0 + lc0, tok = m0 + lrow;
      float y[8], z[8], o[8];
      ld8bf(Y + ((size_t)(col >> 4) * MT + tok) * 16 + (col & 15), y);
      ld8bf(SZS + (size_t)tok * 512 + col, z);
#pragma unroll
      for (int j = 0; j < 8; ++j) o[j] = y[j] * sigmoidf_(v[j] + P.b_glu[col + j]) * z[j];
      st8bf(YS + (size_t)tok * 512 + col, o);
    EPI8_END
  }
}

DI void ph_merge(const Params& P, char* smem) {
  const bf16_t* YS = (const bf16_t*)(P.ws + OFF_U);
  const bf16_t* YA = (const bf16_t*)(P.ws + OFF_YA);
  const bf16_t* SGS = (const bf16_t*)(P.ws + OFF_SGS);
  const bf16_t* SGA = (const bf16_t*)(P.ws + OFF_SGA);
  bf16_t* MG = (bf16_t*)(P.ws + OFF_X0);
  for (int u = blockIdx.x; u < 4096; u += gridDim.x) {
    const int nt = u & 7, mt = u >> 3, m0 = mt * 128, n0 = nt * 128;
    f32x16 acc[2][2];
    float* st = (float*)smem;
    gemm_main<ARow, false>(acc, ARow{YS, 512}, m0, (const bf16_t*)(P.ws + OFF_WBS), 512, n0, 512, smem);
    stage_acc(acc, st);
    EPI8_BEGIN(st, 8, 4)
      const size_t o = (size_t)(m0 + lrow) * 1024 + n0 + lc0;
      float gte[8]; ld8bf(SGS + o, gte);
#pragma unroll
      for (int j = 0; j < 8; ++j) v[j] *= gte[j];
      st8bf(MG + o, v);
    EPI8_END
    gemm_main<ARow, false>(acc, ARow{YA, 512}, m0, (const bf16_t*)(P.ws + OFF_WBA), 512, n0, 512, smem);
    stage_acc(acc, st);
    EPI8_BEGIN(st, 8, 4)
      const size_t o = (size_t)(m0 + lrow) * 1024 + n0 + lc0;
      float gte[8], pr[8]; ld8bf(SGA + o, gte); ld8bf(MG + o, pr);
#pragma unroll
      for (int j = 0; j < 8; ++j) v[j] = pr[j] + v[j] * gte[j];
      st8bf(MG + o, v);
    EPI8_END
  }
}

DI void ph_out(const Params& P, char* smem) {
  const bf16_t* MG = (const bf16_t*)(P.ws + OFF_X0);
  const float2* STATS = (const float2*)(P.ws + OFF_STATS);
  for (int u = blockIdx.x; u < 4096; u += gridDim.x) {
    const int nt = u & 7, mt = u >> 3, m0 = mt * 128, n0 = nt * 128;
    f32x16 acc[2][2];
    gemm_main<ARow, false>(acc, ARow{MG, 1024}, m0, (const bf16_t*)(P.ws + OFF_WO), 1024, n0, 1024, smem);
    float* st = (float*)smem;
    stage_acc(acc, st);
    EPI8_BEGIN(st, 8, 4)
      const int tok = m0 + lrow, col = n0 + lc0;
      const float* xp = tok < 32768 ? P.x_prompt + (size_t)tok * DM + col : P.x_sample + (size_t)(tok - 32768) * DM + col;
      float xv[8], gg[8], bb[8];
      ld8(xp, xv); ld8(P.ln_in_g + col, gg); ld8(P.ln_in_b + col, bb);
      const float2 stt = STATS[tok];
#pragma unroll
      for (int j = 0; j < 8; ++j) v[j] += ALPHA_RES * ((xv[j] - stt.x) * stt.y * gg[j] + bb[j]);
      float* d = P.out + (size_t)tok * DM + col;
      *(float4*)d = make_float4(v[0], v[1], v[2], v[3]); *(float4*)(d + 4) = make_float4(v[4], v[5], v[6], v[7]);
    EPI8_END
  }
}

DI void ph_final_ln(const Params& P) {
  const int gt = blockIdx.x * blockDim.x + threadIdx.x, gs = gridDim.x * blockDim.x;
  const int lane = threadIdx.x & 63, gw = gt >> 6, nw = gs >> 6;
  for (int row = gw; row < MT; row += nw) {
    float* zr = P.out + (size_t)row * DM;
    float4 v[4];
    float s = 0.f;
#pragma unroll
    for (int i = 0; i < 4; ++i) { v[i] = *(const float4*)(zr + i * 256 + lane * 4); s += (v[i].x + v[i].y) + (v[i].z + v[i].w); }
#pragma unroll
    for (int o = 32; o >= 1; o >>= 1) s += __shfl_xor(s, o);
    const float mu = s * (1.f / 1024.f);
    float q = 0.f;
#pragma unroll
    for (int i = 0; i < 4; ++i) { const float a = v[i].x - mu, b = v[i].y - mu, c = v[i].z - mu, d = v[i].w - mu; q += (a * a + b * b) + (c * c + d * d); }
#pragma unroll
    for (int o = 32; o >= 1; o >>= 1) q += __shfl_xor(q, o);
    const float rstd = rsqrtf(q * (1.f / 1024.f) + 1e-5f);
#pragma unroll
    for (int i = 0; i < 4; ++i) {
      const int c = i * 256 + lane * 4;
      const float4 g = *(const float4*)(P.ln_g + c), b = *(const float4*)(P.ln_b + c);
      float4 o;
      o.x = (v[i].x - mu) * rstd * g.x + b.x; o.y = (v[i].y - mu) * rstd * g.y + b.y;
      o.z = (v[i].z - mu) * rstd * g.z + b.z; o.w = (v[i].w - mu) * rstd * g.w + b.w;
      *(float4*)(zr + c) = o;
    }
  }
}

#ifndef N_LAUNCH_MODE
#define N_LAUNCH_MODE 1
#endif

template <int PH> DI void run_phase(const Params& P, char* smem) {
  if (PH == 0) ph_tables(P);
  else if (PH == 1) ph_prep(P, smem);
  else if (PH == 2) ph_g1(P, smem);
  else if (PH == 3) ph_qkv(P, smem);
  else if (PH == 4) ph_scan(P);
  else if (PH == 5) ph_mix(P, smem);
  else if (PH == 6) ph_glu(P, smem);
  else if (PH == 7) ph_merge(P, smem);
  else if (PH == 8) ph_out(P, smem);
  else ph_final_ln(P);
}

#if N_LAUNCH_MODE == 1
__global__ void __launch_bounds__(256, 2) fwd_kernel(Params P_arg) {
  __shared__ __attribute__((aligned(16))) char smem[OFF_RSS + 512];
  cg::grid_group grid = cg::this_grid();
  const Params& P = *(const Params*)__builtin_amdgcn_kernarg_segment_ptr();
  run_phase<0>(P, smem); grid.sync();
  run_phase<1>(P, smem); grid.sync();
  run_phase<2>(P, smem); grid.sync();
  run_phase<3>(P, smem); grid.sync();
  run_phase<4>(P, smem); grid.sync();
  run_phase<5>(P, smem); grid.sync();
  run_phase<6>(P, smem); grid.sync();
  run_phase<7>(P, smem); grid.sync();
  run_phase<8>(P, smem); grid.sync();
  run_phase<9>(P, smem);
}
#else
template <int PH> __global__ void __launch_bounds__(256, 2) phase_kernel(Params P) {
  __shared__ __attribute__((aligned(16))) char smem[OFF_RSS + 512];
  run_phase<PH>(P, smem);
}
#endif

extern "C" void kernel_launch(void* const* d_in, const int* in_sizes, int n_in, void* d_out, int out_size, void* d_ws, size_t ws_size, hipStream_t stream) {
  if (ws_size < WS_NEEDED) { fprintf(stderr, "workspace too small: %zu < %zu\n", ws_size, WS_NEEDED); return; }
  Params p{};
  const float** f = (const float**)&p;
  for (int i = 0; i < 29; ++i) f[i] = (const float*)d_in[i];
  p.out = (float*)d_out;
  p.ws = (char*)d_ws;
  static int grid_blocks = 0;
#if N_LAUNCH_MODE == 1
  if (!grid_blocks) {
    int dev = 0, cus = 0, per_cu = 0;
    (void)hipGetDevice(&dev);
    (void)hipDeviceGetAttribute(&cus, hipDeviceAttributeMultiprocessorCount, dev);
    (void)hipOccupancyMaxActiveBlocksPerMultiprocessor(&per_cu, fwd_kernel, 256, 0);
    if (per_cu > 2) per_cu = 2;
    if (per_cu < 1) per_cu = 1;
    grid_blocks = cus * per_cu;
  }
  void* args[] = {&p};
  hipError_t e = hipLaunchCooperativeKernel((void*)fwd_kernel, dim3(grid_blocks), dim3(256), args, 0, stream);
  if (e != hipSuccess) fprintf(stderr, "cooperative launch failed: %s (grid %d)\n", hipGetErrorString(e), grid_blocks);
#else
  grid_blocks = 512;
  hipLaunchKernelGGL(phase_kernel<0>, dim3(grid_blocks), dim3(256), 0, stream, p);
  hipLaunchKernelGGL(phase_kernel<1>, dim3(grid_blocks), dim3(256), 0, stream, p);
  hipLaunchKernelGGL(phase_kernel<2>, dim3(grid_blocks), dim3(256), 0, stream, p);
  hipLaunchKernelGGL(phase_kernel<3>, dim3(grid_blocks), dim3(256), 0, stream, p);
  hipLaunchKernelGGL(phase_kernel<4>, dim3(grid_blocks), dim3(256), 0, stream, p);
  hipLaunchKernelGGL(phase_kernel<5>, dim3(grid_blocks), dim3(256), 0, stream, p);
  hipLaunchKernelGGL(phase_kernel<6>, dim3(grid_blocks), dim3(256), 0, stream, p);
  hipLaunchKernelGGL(phase_kernel<7>, dim3(grid_blocks), dim3(256), 0, stream, p);
  hipLaunchKernelGGL(phase_kernel<8>, dim3(grid_blocks), dim3(256), 0, stream, p);
  hipLaunchKernelGGL(phase_kernel<9>, dim3(grid_blocks), dim3(256), 0, stream, p);
#endif
}
```

```cpp
#include <hip/hip_runtime.h>
#include <hip/hip_cooperative_groups.h>
#include <cstdint>
#include <cstdio>
namespace cg = cooperative_groups;

#define DI __device__ __forceinline__
typedef unsigned short bf16_t;
typedef short bf16x8 __attribute__((ext_vector_type(8)));
typedef float f32x16 __attribute__((ext_vector_type(16)));
typedef unsigned u32x4 __attribute__((ext_vector_type(4)));
typedef unsigned u32x2 __attribute__((ext_vector_type(2)));

constexpr int MT = 65536;
constexpr int DM = 1024;
constexpr int TCH = 32;
constexpr int NCH = MT / TCH;
constexpr size_t MiB = (size_t)1 << 20;

constexpr size_t OFF_X0 = 0;
constexpr size_t OFF_S = 0;
constexpr size_t OFF_HST = 64 * MiB;
constexpr size_t OFF_U = 128 * MiB;
constexpr size_t OFF_SZS = 192 * MiB;
constexpr size_t OFF_SZA = 256 * MiB;
constexpr size_t OFF_SGS = 320 * MiB;
constexpr size_t OFF_SGA = 448 * MiB;
constexpr size_t OFF_CQ = 576 * MiB;
constexpr size_t OFF_CKV = 608 * MiB;
constexpr size_t OFF_KR = 624 * MiB;
constexpr size_t OFF_YA = 628 * MiB;
constexpr size_t OFF_W1T = 692 * MiB;
constexpr size_t OFF_WUQ = 700 * MiB;
constexpr size_t OFF_WUKV = OFF_WUQ + MiB / 2;
constexpr size_t OFF_WGLU = OFF_WUKV + MiB / 2;
constexpr size_t OFF_WBS = OFF_WGLU + MiB / 2;
constexpr size_t OFF_WBA = OFF_WBS + MiB;
constexpr size_t OFF_WO = OFF_WBA + MiB;
constexpr size_t OFF_WST = OFF_WO + 2 * MiB;
constexpr size_t OFF_WOUT = OFF_WST + 8 * MiB;
constexpr size_t OFF_LP = OFF_WOUT + 24 * MiB;
constexpr size_t OFF_BT = OFF_LP + 2 * MiB;
constexpr size_t OFF_KT = OFF_BT + MiB;
constexpr size_t OFF_ROPE = OFF_KT + 2 * MiB;
constexpr size_t OFF_STATS = OFF_ROPE + 2 * MiB;
constexpr size_t WS_NEEDED = OFF_STATS + MiB;
constexpr size_t OFF_Q = 0;
constexpr size_t OFF_K = 96 * MiB;
constexpr size_t OFF_VT = 192 * MiB;

constexpr float ALPHA_RES = 1.18920711500272f;
constexpr float QSCALE = 0.14724444f;

struct Params {
  const float *x_prompt, *x_sample, *ln_in_g, *ln_in_b, *w_in, *b_re, *b_im, *a_re_f, *a_im_f, *ldt_f, *c_re_f, *c_im_f, *a_re_b, *a_im_b,
      *ldt_b, *c_re_b, *c_im_b, *ssm_d, *w_glu, *b_glu, *q_norm_g, *w_uq, *kv_norm_g, *w_ukv, *w_bs, *w_ba, *w_o, *ln_g, *ln_b;
  float* out;
  char* ws;
  int pad0, pad1;
};

DI bf16_t f2bf(float x) { unsigned u = __float_as_uint(x); u += 0x7fffu + ((u >> 16) & 1u); return (bf16_t)(u >> 16); }
DI unsigned pk2(float lo, float hi) { unsigned r; asm("v_cvt_pk_bf16_f32 %0, %1, %2" : "=v"(r) : "v"(lo), "v"(hi)); return r; }
DI float bf2f(bf16_t b) { return __uint_as_float(((unsigned)b) << 16); }
DI float sigmoidf_(float x) { return __builtin_amdgcn_rcpf(1.f + __expf(-x)); }
DI float siluf_(float x) { return x * sigmoidf_(x); }
DI float geluf_(float x) { return x * sigmoidf_(1.5957691216057308f * (x + 0.044715f * x * x * x)); }
DI int crow(int i, int h) { return (i & 3) + 8 * (i >> 2) + 4 * h; }
DI int tok_pos(int t) { return t < 32768 ? (t & 16383) : (t & 8191); }

DI void sincos2pi(double rev, double& s, double& c) {
  rev -= rint(rev);
  double q = rint(rev * 4.0);
  double y = (rev - q * 0.25) * 6.283185307179586476925;
  double y2 = y * y;
  double sp = y * (1.0 + y2 * (-1.0 / 6 + y2 * (1.0 / 120 + y2 * (-1.0 / 5040 + y2 * (1.0 / 362880 + y2 * (-1.0 / 39916800 + y2 * (1.0 / 6227020800.0)))))));
  double cp = 1.0 + y2 * (-0.5 + y2 * (1.0 / 24 + y2 * (-1.0 / 720 + y2 * (1.0 / 40320 + y2 * (-1.0 / 3628800 + y2 * (1.0 / 479001600.0 + y2 * (-1.0 / 87178291200.0)))))));
  int qi = ((int)q) & 3;
  if (qi == 0) { s = sp; c = cp; } else if (qi == 1) { s = cp; c = -sp; } else if (qi == 2) { s = -sp; c = -cp; } else { s = -cp; c = sp; }
}

struct ARow { const bf16_t* p; int ld; DI const bf16_t* operator()(int row, int kc) const { return p + (size_t)row * ld + kc * 8; } };
struct ATwo { const bf16_t* p1; int ld1; int kc1; const bf16_t* p2; int ld2;
  DI const bf16_t* operator()(int row, int kc) const { return kc < kc1 ? p1 + (size_t)row * ld1 + kc * 8 : p2 + (size_t)row * ld2 + (kc - kc1) * 8; } };
struct AGrp { const bf16_t* p; DI const bf16_t* operator()(int row, int kc) const { return p + ((size_t)(kc >> 1) * MT + row) * 16 + (kc & 1) * 8; } };

constexpr int STL = 132;
constexpr int OFF_RSS = 128 * STL * 4;
DI int swz(int row, int c) { return row * 128 + ((c ^ ((row >> 1) & 7)) << 4); }

template <class AL, bool ROWSS>
DI void gemm_main1(f32x16 (&acc)[2][2], const AL& al, int m0, const bf16_t* __restrict__ Bt, int ldb, int n0, int K, char* smem) {
  const int tid = threadIdx.x, lane = tid & 63, wave = tid >> 6, wm = wave >> 1, wn = wave & 1, r = lane & 31, h = lane >> 5;
  const int srow = tid >> 3, sch = tid & 7;
  u32x4 ra[4], rb[4];
  float ss[4] = {0.f, 0.f, 0.f, 0.f};
  const int nk = K >> 6;
#pragma unroll
  for (int mi = 0; mi < 2; ++mi)
#pragma unroll
    for (int ni = 0; ni < 2; ++ni)
#pragma unroll
      for (int i = 0; i < 16; ++i) acc[mi][ni][i] = 0.f;
#pragma unroll
  for (int i = 0; i < 4; ++i) {
    ra[i] = *(const u32x4*)al(m0 + srow + 32 * i, sch);
    rb[i] = *(const u32x4*)(Bt + (size_t)(n0 + srow + 32 * i) * ldb + sch * 8);
  }
  for (int kt = 0; kt < nk; ++kt) {
    char* sa = smem + (kt & 1) * 32768;
    char* sb = sa + 16384;
#pragma unroll
    for (int i = 0; i < 4; ++i) {
      const int off = swz(srow + 32 * i, sch);
      *(u32x4*)(sa + off) = ra[i];
      *(u32x4*)(sb + off) = rb[i];
      if (ROWSS) {
#pragma unroll
        for (int j = 0; j < 4; ++j) { float lo = __uint_as_float(ra[i][j] << 16), hi = __uint_as_float(ra[i][j] & 0xffff0000u); ss[i] += lo * lo + hi * hi; }
      }
    }
    __syncthreads();
    if (kt + 1 < nk) {
#pragma unroll
      for (int i = 0; i < 4; ++i) {
        ra[i] = *(const u32x4*)al(m0 + srow + 32 * i, (kt + 1) * 8 + sch);
        rb[i] = *(const u32x4*)(Bt + (size_t)(n0 + srow + 32 * i) * ldb + (kt + 1) * 64 + sch * 8);
      }
    }
#pragma unroll
    for (int ks = 0; ks < 4; ++ks) {
      bf16x8 af[2], bfr[2];
#pragma unroll
      for (int mi = 0; mi < 2; ++mi) af[mi] = *(const bf16x8*)(sa + swz(wm * 64 + mi * 32 + r, ks * 2 + h));
#pragma unroll
      for (int ni = 0; ni < 2; ++ni) bfr[ni] = *(const bf16x8*)(sb + swz(wn * 64 + ni * 32 + r, ks * 2 + h));
#pragma unroll
      for (int mi = 0; mi < 2; ++mi)
#pragma unroll
        for (int ni = 0; ni < 2; ++ni) acc[mi][ni] = __builtin_amdgcn_mfma_f32_32x32x16_bf16(af[mi], bfr[ni], acc[mi][ni], 0, 0, 0);
    }
  }
  __syncthreads();
  if (ROWSS) {
    float* rss = (float*)(smem + OFF_RSS);
#pragma unroll
    for (int i = 0; i < 4; ++i) {
      float v = ss[i];
      v += __shfl_xor(v, 1); v += __shfl_xor(v, 2); v += __shfl_xor(v, 4);
      if (sch == 0) rss[srow + 32 * i] = v;
    }
    __syncthreads();
  }
}

template <class AL, bool ROWSS>
DI void gemm_main(f32x16 (&acc)[2][2], const AL& al, int m0, const bf16_t* __restrict__ Bt, int ldb, int n0, int K, char* smem) {
  const int tid = threadIdx.x, lane = tid & 63, wave = tid >> 6, wm = wave >> 1, wn = wave & 1, r = lane & 31, h = lane >> 5;
  const int srow = tid >> 3, sch = tid & 7;
  u32x4 ra[3][4], rb[3][4];
  float ss[4] = {0.f, 0.f, 0.f, 0.f};
  const int nk = K >> 6;
#pragma unroll
  for (int mi = 0; mi < 2; ++mi)
#pragma unroll
    for (int ni = 0; ni < 2; ++ni)
#pragma unroll
      for (int i = 0; i < 16; ++i) acc[mi][ni][i] = 0.f;
#define GLOAD(SET, KT)                                                                                   \
  _Pragma("unroll") for (int i = 0; i < 4; ++i) {                                                        \
    ra[SET][i] = *(const u32x4*)al(m0 + srow + 32 * i, (KT) * 8 + sch);                                  \
    rb[SET][i] = *(const u32x4*)(Bt + (size_t)(n0 + srow + 32 * i) * ldb + (KT) * 64 + sch * 8);         \
  }
  GLOAD(0, 0)
  if (1 < nk) { GLOAD(1, 1) }
  if (2 < nk) { GLOAD(2, 2) }
#define GSTEP(SET, KT)                                                                                   \
  if ((KT) < nk) {                                                                                       \
    char* sa = smem + ((KT) & 1) * 32768;                                                                \
    char* sb = sa + 16384;                                                                               \
    _Pragma("unroll") for (int i = 0; i < 4; ++i) {                                                      \
      const int off = swz(srow + 32 * i, sch);                                                           \
      *(u32x4*)(sa + off) = ra[SET][i];                                                                  \
      *(u32x4*)(sb + off) = rb[SET][i];                                                                  \
      if (ROWSS) {                                                                                       \
        _Pragma("unroll") for (int j = 0; j < 4; ++j) {                                                  \
          const float lo = __uint_as_float(ra[SET][i][j] << 16), hi = __uint_as_float(ra[SET][i][j] & 0xffff0000u); \
          ss[i] += lo * lo + hi * hi; }                                                                  \
      }                                                                                                  \
    }                                                                                                    \
    __syncthreads();                                                                                     \
    if ((KT) + 3 < nk) { GLOAD(SET, (KT) + 3) }                                                          \
    _Pragma("unroll") for (int ks = 0; ks < 4; ++ks) {                                                   \
      bf16x8 af[2], bfr[2];                                                                              \
      _Pragma("unroll") for (int mi = 0; mi < 2; ++mi) af[mi] = *(const bf16x8*)(sa + swz(wm * 64 + mi * 32 + r, ks * 2 + h)); \
      _Pragma("unroll") for (int ni = 0; ni < 2; ++ni) bfr[ni] = *(const bf16x8*)(sb + swz(wn * 64 + ni * 32 + r, ks * 2 + h)); \
      _Pragma("unroll") for (int mi = 0; mi < 2; ++mi)                                                   \
        _Pragma("unroll") for (int ni = 0; ni < 2; ++ni) acc[mi][ni] = __builtin_amdgcn_mfma_f32_32x32x16_bf16(af[mi], bfr[ni], acc[mi][ni], 0, 0, 0); \
    }                                                                                                    \
  }
  for (int kt = 0; kt < nk; kt += 3) {
    GSTEP(0, kt)
    GSTEP(1, kt + 1)
    GSTEP(2, kt + 2)
  }
#undef GSTEP
#undef GLOAD
  __syncthreads();
  if (ROWSS) {
    float* rss = (float*)(smem + OFF_RSS);
#pragma unroll
    for (int i = 0; i < 4; ++i) {
      float v = ss[i];
      v += __shfl_xor(v, 1); v += __shfl_xor(v, 2); v += __shfl_xor(v, 4);
      if (sch == 0) rss[srow + 32 * i] = v;
    }
    __syncthreads();
  }
}

DI void stage_acc(const f32x16 (&acc)[2][2], float* st) {
  const int lane = threadIdx.x & 63, wave = threadIdx.x >> 6, wm = wave >> 1, wn = wave & 1, r = lane & 31, h = lane >> 5;
#pragma unroll
  for (int mi = 0; mi < 2; ++mi)
#pragma unroll
    for (int ni = 0; ni < 2; ++ni)
#pragma unroll
      for (int i = 0; i < 16; ++i) st[(wm * 64 + mi * 32 + crow(i, h)) * STL + wn * 64 + ni * 32 + r] = acc[mi][ni][i];
  __syncthreads();
}
DI void ld8(const float* st, float (&v)[8]) { const float4 a = *(const float4*)st, b = *(const float4*)(st + 4); v[0] = a.x; v[1] = a.y; v[2] = a.z; v[3] = a.w; v[4] = b.x; v[5] = b.y; v[6] = b.z; v[7] = b.w; }
DI void ld8bf(const bf16_t* p, float (&v)[8]) {
  const u32x4 w = *(const u32x4*)p;
#pragma unroll
  for (int j = 0; j < 4; ++j) { v[2 * j] = __uint_as_float(w[j] << 16); v[2 * j + 1] = __uint_as_float(w[j] & 0xffff0000u); }
}
DI void st8bf(bf16_t* p, const float (&v)[8]) { u32x4 w; w.x = pk2(v[0], v[1]); w.y = pk2(v[2], v[3]); w.z = pk2(v[4], v[5]); w.w = pk2(v[6], v[7]); *(u32x4*)p = w; }
#define EPI8_BEGIN(st, NIT, CSH)                                              \
  _Pragma("unroll 1") for (int it_ = 0; it_ < (NIT); ++it_) {                   \
    const int gid_ = it_ * 256 + threadIdx.x; const int lrow = gid_ >> (CSH), lc0 = (gid_ & ((1 << (CSH)) - 1)) * 8; \
    float v[8]; ld8((st) + lrow * STL + lc0, v);
#define EPI8_END } __syncthreads();

DI void ph_tables(const Params& P) {
  const int gt = blockIdx.x * blockDim.x + threadIdx.x, gs = gridDim.x * blockDim.x;
  float2* LP = (float2*)(P.ws + OFF_LP);
  float2* BT = (float2*)(P.ws + OFF_BT);
  float2* ROPE = (float2*)(P.ws + OFF_ROPE);
  for (int idx = gt; idx < 32 * 2 * 64; idx += gs) {
    const int n = idx & 63, dir = (idx >> 6) & 1, g = idx >> 7;
    const double are = dir ? (double)P.a_re_b[g * 64 + n] : (double)P.a_re_f[g * 64 + n];
    const double aim = dir ? (double)P.a_im_b[g * 64 + n] : (double)P.a_im_f[g * 64 + n];
    const double dt = exp(dir ? (double)P.ldt_b[g] : (double)P.ldt_f[g]);
    double l1r = 1.0, l1i = 0.0;
    for (int d = 0; d <= 32; ++d) {
      const double mag = exp(are * dt * d);
      double s, c; sincos2pi(aim * dt * d * 0.15915494309189533577, s, c);
      LP[((g * 2 + dir) * 33 + d) * 64 + n] = make_float2((float)(mag * c), (float)(mag * s));
      if (d == 1) { l1r = mag * c; l1i = mag * s; }
    }
    const double zr = are * dt, zi = aim * dt;
    double cr, ci;
    if (zr * zr + zi * zi < 0.25) {
      double tr = 1.0, ti = 0.0, sr = 1.0, si = 0.0;
      for (int k = 1; k < 24; ++k) { const double nr = (tr * zr - ti * zi) / (k + 1), ni = (tr * zi + ti * zr) / (k + 1); tr = nr; ti = ni; sr += tr; si += ti; }
      cr = sr * dt; ci = si * dt;
    } else {
      const double nr = l1r - 1.0, ni = l1i, den = are * are + aim * aim;
      cr = (nr * are + ni * aim) / den; ci = (ni * are - nr * aim) / den;
    }
    for (int q = 0; q < 16; ++q) {
      const double br = P.b_re[(g * 64 + n) * 16 + q], bi = P.b_im[(g * 64 + n) * 16 + q];
      BT[((g * 2 + dir) * 64 + n) * 16 + q] = make_float2((float)(br * cr - bi * ci), (float)(br * ci + bi * cr));
    }
  }
  for (int idx = gt; idx < 16384 * 16; idx += gs) {
    const int j = idx & 15, pos = idx >> 4;
    const double inv = exp(-(double)j * (9.210340371976182736 / 16.0));
    double s, c; sincos2pi((double)pos * inv * 0.15915494309189533577, s, c);
    ROPE[idx] = make_float2((float)c, (float)s);
  }
}

DI void transpose_tile(const float* __restrict__ src, int lds_, int K, bf16_t* __restrict__ dst, int k0, int n0, int mode, const float* __restrict__ rowscale, float* tile) {
  const int tid = threadIdx.x;
  {
    const int nn = tid & 63, n = n0 + nn;
    int sc = n;
    if (mode == 1) sc = n < 1440 ? n : (n < 1536 ? -1 : n - 96);
#pragma unroll 4
    for (int i = 0; i < 16; ++i) {
      const int kk = (tid >> 6) + 4 * i, k = k0 + kk;
      float v = sc >= 0 ? src[(size_t)k * lds_ + sc] : 0.f;
      if (rowscale) v *= rowscale[k];
      tile[kk * 65 + nn] = v;
    }
  }
  __syncthreads();
  {
    const int kk = tid & 63;
#pragma unroll 4
    for (int i = 0; i < 16; ++i) { const int nn = (tid >> 6) + 4 * i; dst[(size_t)(n0 + nn) * K + k0 + kk] = f2bf(tile[kk * 65 + nn]); }
  }
  __syncthreads();
}

DI void ph_prep(const Params& P, char* smem) {
  const int gt = blockIdx.x * blockDim.x + threadIdx.x, gs = gridDim.x * blockDim.x;
  const float2* LP = (const float2*)(P.ws + OFF_LP);
  const float2* BT = (const float2*)(P.ws + OFF_BT);
  float* KT = (float*)(P.ws + OFF_KT);
  bf16_t* WST = (bf16_t*)(P.ws + OFF_WST);
  bf16_t* WOUT = (bf16_t*)(P.ws + OFF_WOUT);
  for (int idx = gt; idx < 32 * 2 * 32 * 256; idx += gs) {
    const int q = idx & 15, p = (idx >> 4) & 15, d = (idx >> 8) & 31, dir = (idx >> 13) & 1, g = idx >> 14;
    const float* cre = (dir ? P.c_re_b : P.c_re_f) + (g * 16 + p) * 64;
    const float* cim = (dir ? P.c_im_b : P.c_im_f) + (g * 16 + p) * 64;
    const float2* lp = LP + ((g * 2 + dir) * 33 + d) * 64;
    const float2* bt = BT + ((g * 2 + dir) * 64) * 16 + q;
    float s = 0.f;
    for (int n = 0; n < 64; ++n) {
      const float2 l = lp[n], b = bt[n * 16];
      const float wr = l.x * b.x - l.y * b.y, wi = l.x * b.y + l.y * b.x;
      s += cre[n] * wr - cim[n] * wi;
    }
    KT[idx] = s;
  }
  for (int idx = gt; idx < 32 * 256 * 512; idx += gs) {
    const int k = idx & 511, np = (idx >> 9) & 255, g = idx >> 17;
    const int q = k & 15, s = k >> 4, n = np & 63, reim = (np >> 6) & 1, dir = np >> 7;
    const int e = dir ? s : (TCH - 1 - s);
    const float2 l = LP[((g * 2 + dir) * 33 + e) * 64 + n], b = BT[((g * 2 + dir) * 64 + n) * 16 + q];
    const float val = reim ? (l.x * b.y + l.y * b.x) : (l.x * b.x - l.y * b.y);
    WST[idx] = f2bf(val);
  }
  for (int idx = gt; idx < 32 * 512 * 256; idx += gs) {
    const int k2 = idx & 255, tp = (idx >> 8) & 511, g = idx >> 17;
    const int n = k2 & 63, reim = (k2 >> 6) & 1, dir = k2 >> 7, p = tp & 15, t = tp >> 4;
    const int e = dir ? (TCH - t) : (t + 1);
    const float2 l = LP[((g * 2 + dir) * 33 + e) * 64 + n];
    const float cr = (dir ? P.c_re_b : P.c_re_f)[(g * 16 + p) * 64 + n], ci = (dir ? P.c_im_b : P.c_im_f)[(g * 16 + p) * 64 + n];
    const float val = reim ? -(cr * l.y + ci * l.x) : (cr * l.x - ci * l.y);
#ifdef PROBE_NO_CONV
    WOUT[((size_t)g * 512 + tp) * 768 + 512 + k2] = 0;
#else
    WOUT[((size_t)g * 512 + tp) * 768 + 512 + k2] = f2bf(val);
#endif
  }
  {
    float* tile = (float*)smem;
    for (int u = blockIdx.x; u < 1680; u += gridDim.x) {
      if (u < 1024) transpose_tile(P.w_in, 4000, 1024, (bf16_t*)(P.ws + OFF_W1T), (u & 15) * 64, (u >> 4) * 64, 1, nullptr, tile);
      else if (u < 1072) { const int v = u - 1024; transpose_tile(P.w_uq, 768, 256, (bf16_t*)(P.ws + OFF_WUQ), (v & 3) * 64, (v >> 2) * 64, 0, P.q_norm_g, tile); }
      else if (u < 1104) { const int v = u - 1072; transpose_tile(P.w_ukv, 1024, 128, (bf16_t*)(P.ws + OFF_WUKV), (v & 1) * 64, (v >> 1) * 64, 0, P.kv_norm_g, tile); }
      else if (u < 1168) { const int v = u - 1104; transpose_tile(P.w_glu, 512, 512, (bf16_t*)(P.ws + OFF_WGLU), (v & 7) * 64, (v >> 3) * 64, 0, nullptr, tile); }
      else if (u < 1296) { const int v = u - 1168; transpose_tile(P.w_bs, 1024, 512, (bf16_t*)(P.ws + OFF_WBS), (v & 7) * 64, (v >> 3) * 64, 0, nullptr, tile); }
      else if (u < 1424) { const int v = u - 1296; transpose_tile(P.w_ba, 1024, 512, (bf16_t*)(P.ws + OFF_WBA), (v & 7) * 64, (v >> 3) * 64, 0, nullptr, tile); }
      else { const int v = u - 1424; transpose_tile(P.w_o, 1024, 1024, (bf16_t*)(P.ws + OFF_WO), (v & 15) * 64, (v >> 4) * 64, 0, nullptr, tile); }
    }
  }
  {
    bf16_t* X0 = (bf16_t*)(P.ws + OFF_X0);
    float2* STATS = (float2*)(P.ws + OFF_STATS);
    const int lane = threadIdx.x & 63, gw = gt >> 6, nw = gs >> 6;
    for (int row = gw; row < MT; row += nw) {
      const float* xr = row < 32768 ? P.x_prompt + (size_t)row * DM : P.x_sample + (size_t)(row - 32768) * DM;
      float4 v[4];
      float s = 0.f;
#pragma unroll
      for (int i = 0; i < 4; ++i) { v[i] = *(const float4*)(xr + i * 256 + lane * 4); s += (v[i].x + v[i].y) + (v[i].z + v[i].w); }
#pragma unroll
      for (int o = 32; o >= 1; o >>= 1) s += __shfl_xor(s, o);
      const float mu = s * (1.f / 1024.f);
      float q = 0.f;
#pragma unroll
      for (int i = 0; i < 4; ++i) { const float a = v[i].x - mu, b = v[i].y - mu, c = v[i].z - mu, d = v[i].w - mu; q += (a * a + b * b) + (c * c + d * d); }
#pragma unroll
      for (int o = 32; o >= 1; o >>= 1) q += __shfl_xor(q, o);
      const float rstd = rsqrtf(q * (1.f / 1024.f) + 1e-5f);
      if (lane == 0) STATS[row] = make_float2(mu, rstd);
#pragma unroll
      for (int i = 0; i < 4; ++i) {
        const int c = i * 256 + lane * 4;
        const float4 g = *(const float4*)(P.ln_in_g + c), b = *(const float4*)(P.ln_in_b + c);
        u32x2 o;
        o.x = pk2((v[i].x - mu) * rstd * g.x + b.x, (v[i].y - mu) * rstd * g.y + b.y);
        o.y = pk2((v[i].z - mu) * rstd * g.z + b.z, (v[i].w - mu) * rstd * g.w + b.w);
        *(u32x2*)(X0 + (size_t)row * DM + c) = o;
      }
    }
  }
}

DI void ph_g1(const Params& P, char* smem) {
  const int gt = blockIdx.x * blockDim.x + threadIdx.x, gs = gridDim.x * blockDim.x;
  {
    const float* KT = (const float*)(P.ws + OFF_KT);
    bf16_t* WOUT = (bf16_t*)(P.ws + OFF_WOUT);
    for (int idx = gt; idx < 32 * 512 * 512; idx += gs) {
      const int k = idx & 511, tp = (idx >> 9) & 511, g = idx >> 18;
      const int q = k & 15, s = k >> 4, p = tp & 15, t = tp >> 4;
      float val;
      if (s < t) val = KT[(((g * 2 + 0) * 32 + (t - s)) * 16 + p) * 16 + q];
      else if (s > t) val = KT[(((g * 2 + 1) * 32 + (s - t)) * 16 + p) * 16 + q];
      else val = KT[(((g * 2 + 0) * 32) * 16 + p) * 16 + q] + KT[(((g * 2 + 1) * 32) * 16 + p) * 16 + q] + (p == q ? P.ssm_d[g * 16 + p] : 0.f);
#ifdef PROBE_NO_CONV
      val = (s == t && p == q) ? P.ssm_d[g * 16 + p] : 0.f;
#endif
      WOUT[((size_t)g * 512 + tp) * 768 + k] = f2bf(val);
    }
  }
  const bf16_t* X0 = (const bf16_t*)(P.ws + OFF_X0);
  const bf16_t* W1T = (const bf16_t*)(P.ws + OFF_W1T);
  bf16_t* U = (bf16_t*)(P.ws + OFF_U);
  bf16_t* SZS = (bf16_t*)(P.ws + OFF_SZS);
  bf16_t* SZA = (bf16_t*)(P.ws + OFF_SZA);
  bf16_t* SGS = (bf16_t*)(P.ws + OFF_SGS);
  bf16_t* SGA = (bf16_t*)(P.ws + OFF_SGA);
  bf16_t* CQ = (bf16_t*)(P.ws + OFF_CQ);
  bf16_t* CKV = (bf16_t*)(P.ws + OFF_CKV);
  bf16_t* KR = (bf16_t*)(P.ws + OFF_KR);
  const float2* ROPE = (const float2*)(P.ws + OFF_ROPE);
  for (int tile = blockIdx.x; tile < 512 * 32; tile += gridDim.x) {
    const int nt = tile & 31, mt = tile >> 5, m0 = mt * 128, n0 = nt * 128;
    f32x16 acc[2][2];
    gemm_main<ARow, false>(acc, ARow{X0, 1024}, m0, W1T, 1024, n0, 1024, smem);
    float* st = (float*)smem;
    stage_acc(acc, st);
    if (nt < 4) {
      EPI8_BEGIN(st, 8, 4) const int col = n0 + lc0; st8bf(U + ((size_t)(col >> 4) * MT + m0 + lrow) * 16 + (col & 15), v); EPI8_END
    } else if (nt < 8) {
      EPI8_BEGIN(st, 8, 4)
#pragma unroll
        for (int j = 0; j < 8; ++j) v[j] = siluf_(v[j]);
        st8bf(SZS + (size_t)(m0 + lrow) * 512 + n0 - 512 + lc0, v);
      EPI8_END
    } else if (nt < 10) {
      EPI8_BEGIN(st, 8, 4) st8bf(CQ + (size_t)(m0 + lrow) * 256 + n0 - 1024 + lc0, v); EPI8_END
    } else if (nt == 10) {
      EPI8_BEGIN(st, 8, 4) st8bf(CKV + (size_t)(m0 + lrow) * 128 + lc0, v); EPI8_END
    } else if (nt == 11) {
      EPI8_BEGIN(st, 8, 4)
        if (lc0 < 32) {
          const int tok = m0 + lrow; const float2* cs = ROPE + tok_pos(tok) * 16 + (lc0 & 15);
          float pv[8]; ld8(st + lrow * STL + (lc0 ^ 16), pv);
          float o[8];
#pragma unroll
          for (int j = 0; j < 8; ++j) o[j] = lc0 < 16 ? v[j] * cs[j].x - pv[j] * cs[j].y : pv[j] * cs[j].y + v[j] * cs[j].x;
          st8bf(KR + (size_t)tok * 32 + lc0, o);
        }
      EPI8_END
    } else if (nt < 16) {
      EPI8_BEGIN(st, 8, 4)
#pragma unroll
        for (int j = 0; j < 8; ++j) v[j] = siluf_(v[j]);
        st8bf(SZA + (size_t)(m0 + lrow) * 512 + n0 - 1536 + lc0, v);
      EPI8_END
    } else if (nt < 24) {
      EPI8_BEGIN(st, 8, 4)
#pragma unroll
        for (int j = 0; j < 8; ++j) v[j] = sigmoidf_(v[j]);
        st8bf(SGS + (size_t)(m0 + lrow) * 1024 + n0 - 2048 + lc0, v);
      EPI8_END
    } else {
      EPI8_BEGIN(st, 8, 4)
#pragma unroll
        for (int j = 0; j < 8; ++j) v[j] = sigmoidf_(v[j]);
        st8bf(SGA + (size_t)(m0 + lrow) * 1024 + n0 - 3072 + lc0, v);
      EPI8_END
    }
  }
}

DI void ph_qkv(const Params& P, char* smem) {
  const bf16_t* CQ = (const bf16_t*)(P.ws + OFF_CQ);
  const bf16_t* CKV = (const bf16_t*)(P.ws + OFF_CKV);
  const bf16_t* KR = (const bf16_t*)(P.ws + OFF_KR);
  const bf16_t* U = (const bf16_t*)(P.ws + OFF_U);
  const float2* ROPE = (const float2*)(P.ws + OFF_ROPE);
  bf16_t* Q = (bf16_t*)((char*)P.out + OFF_Q);
  bf16_t* KM = (bf16_t*)((char*)P.out + OFF_K);
  bf16_t* VT = (bf16_t*)((char*)P.out + OFF_VT);
  float* S = (float*)(P.ws + OFF_S);
  const float* rss = (const float*)(smem + OFF_RSS);
  float* st = (float*)smem;
  const int NU = 3072 + 4096 + 1024;
  for (int u = blockIdx.x; u < NU; u += gridDim.x) {
    f32x16 acc[2][2];
    if (u < 3072) {
      const int nt = u % 6, mt = u / 6, m0 = mt * 128, n0 = nt * 128;
      gemm_main1<ARow, true>(acc, ARow{CQ, 256}, m0, (const bf16_t*)(P.ws + OFF_WUQ), 256, n0, 256, smem);
      stage_acc(acc, st);
      EPI8_BEGIN(st, 8, 4)
        const int col = n0 + lc0, head = col / 96, c = col - head * 96, tok = m0 + lrow;
        const float sc = rsqrtf(rss[lrow] * (1.f / 256.f) + 1e-6f) * QSCALE;
        float o[8];
        if (c >= 64) {
          const float2* cs = ROPE + tok_pos(tok) * 16 + (c & 15);
          float pv[8]; ld8(st + lrow * STL + (lc0 ^ 16), pv);
#pragma unroll
          for (int j = 0; j < 8; ++j) o[j] = ((c & 16) ? pv[j] * cs[j].y + v[j] * cs[j].x : v[j] * cs[j].x - pv[j] * cs[j].y) * sc;
        } else {
#pragma unroll
          for (int j = 0; j < 8; ++j) o[j] = v[j] * sc;
        }
        st8bf(Q + ((size_t)head * MT + tok) * 96 + c, o);
      EPI8_END
    } else if (u < 3072 + 4096) {
      const int v2 = u - 3072, head = v2 & 7, mt = v2 >> 3, m0 = mt * 128, n0 = head * 128;
      gemm_main1<ARow, true>(acc, ARow{CKV, 128}, m0, (const bf16_t*)(P.ws + OFF_WUKV), 128, n0, 128, smem);
      stage_acc(acc, st);
#pragma unroll 1
      for (int it = 0; it < 4; ++it) {
        const int gid = it * 256 + threadIdx.x, lrow = gid >> 3, lc0 = (gid & 7) * 8, tok = m0 + lrow;
        const float sc = rsqrtf(rss[lrow] * (1.f / 128.f) + 1e-6f);
        float v[8]; ld8(st + lrow * STL + lc0, v);
#pragma unroll
        for (int j = 0; j < 8; ++j) v[j] *= sc;
        st8bf(KM + ((size_t)head * MT + tok) * 96 + lc0, v);
      }
#pragma unroll 1
      for (int it = 0; it < 4; ++it) {
        const int gid = it * 256 + threadIdx.x, dv = gid >> 4, rg = (gid & 15) * 8;
        float v[8];
#pragma unroll
        for (int j = 0; j < 8; ++j) v[j] = st[(rg + j) * STL + 64 + dv] * rsqrtf(rss[rg + j] * (1.f / 128.f) + 1e-6f);
        st8bf(VT + ((size_t)head * 64 + dv) * MT + m0 + rg, v);
      }
      {
        const int tok = m0 + (threadIdx.x >> 1), hf = threadIdx.x & 1;
        const u32x4* sp = (const u32x4*)(KR + (size_t)tok * 32 + hf * 16);
        u32x4* d = (u32x4*)(KM + ((size_t)head * MT + tok) * 96 + 64 + hf * 16);
        d[0] = sp[0]; d[1] = sp[1];
      }
      __syncthreads();
    } else {
      const int v2 = u - 7168, nt = v2 & 1, mt = (v2 >> 1) & 15, g = v2 >> 5, m0 = mt * 128, n0 = nt * 128;
      gemm_main1<ARow, false>(acc, ARow{U + (size_t)g * MT * 16, 512}, m0, (const bf16_t*)(P.ws + OFF_WST) + (size_t)g * 256 * 512, 512, n0, 512, smem);
      stage_acc(acc, st);
      EPI8_BEGIN(st, 8, 4)
        float* d = S + ((size_t)g * NCH + m0 + lrow) * 256 + n0 + lc0;
        *(float4*)d = make_float4(v[0], v[1], v[2], v[3]); *(float4*)(d + 4) = make_float4(v[4], v[5], v[6], v[7]);
      EPI8_END
    }
  }
}

DI void ph_scan(const Params& P) {
  const int gt = blockIdx.x * blockDim.x + threadIdx.x, gs = gridDim.x * blockDim.x;
  const float* S = (const float*)(P.ws + OFF_S);
  bf16_t* HST = (bf16_t*)(P.ws + OFF_HST);
  const float2* LP = (const float2*)(P.ws + OFF_LP);
  for (int idx = gt; idx < 6 * 32 * 2 * 64; idx += gs) {
    const int n = idx & 63, dir = (idx >> 6) & 1, g = (idx >> 7) & 31, seq = idx >> 12;
    const int c0 = seq < 2 ? seq * 512 : 1024 + (seq - 2) * 256, nc = seq < 2 ? 512 : 256;
    const float2 a = LP[((g * 2 + dir) * 33 + 32) * 64 + n];
    float hr = 0.f, hi = 0.f;
    const float* Sg = S + (size_t)g * NCH * 256 + dir * 128 + n;
    bf16_t* Hg = HST + (size_t)g * NCH * 256 + dir * 128 + n;
    for (int cb = 0; cb < nc; cb += 8) {
      float sr[8], si[8];
#pragma unroll
      for (int j = 0; j < 8; ++j) { const int c = dir ? (c0 + nc - 1 - cb - j) : (c0 + cb + j); sr[j] = Sg[(size_t)c * 256]; si[j] = Sg[(size_t)c * 256 + 64]; }
#pragma unroll
      for (int j = 0; j < 8; ++j) {
        const int c = dir ? (c0 + nc - 1 - cb - j) : (c0 + cb + j);
        Hg[(size_t)c * 256] = f2bf(hr); Hg[(size_t)c * 256 + 64] = f2bf(hi);
        const float nr = a.x * hr - a.y * hi + sr[j], ni = a.x * hi + a.y * hr + si[j];
        hr = nr; hi = ni;
      }
    }
  }
}

DI void attn_unit(const Params& P, int tok0, int L, int head, int q0, char* smem) {
  const int tid = threadIdx.x, lane = tid & 63, wave = tid >> 6, r = lane & 31, h = lane >> 5;
  const bf16_t* Qh = (const bf16_t*)((char*)P.out + OFF_Q) + (size_t)head * MT * 96;
  const bf16_t* Kh = (const bf16_t*)((char*)P.out + OFF_K) + ((size_t)head * MT + tok0) * 96;
  const bf16_t* Vh = (const bf16_t*)((char*)P.out + OFF_VT) + (size_t)head * 64 * MT + tok0;
  const bf16_t* SZA = (const bf16_t*)(P.ws + OFF_SZA);
  bf16_t* YA = (bf16_t*)(P.ws + OFF_YA);
  const int qtok = tok0 + q0 + wave * 32 + r;
  bf16x8 qf[6];
#pragma unroll
  for (int ks = 0; ks < 6; ++ks) qf[ks] = *(const bf16x8*)(Qh + (size_t)qtok * 96 + ks * 16 + h * 8);
  f32x16 O[2];
  f32x16 negm;
#pragma unroll
  for (int i = 0; i < 16; ++i) { O[0][i] = 0.f; O[1][i] = 0.f; negm[i] = 0.f; }
  float l = 0.f;
  u32x4 rk[3], rv[2];
  int kgo[3], klo[3];
#pragma unroll
  for (int i = 0; i < 3; ++i) { const int id = tid + 256 * i, kr = id / 12, kc = id - kr * 12; kgo[i] = kr * 96 + kc * 8; klo[i] = kr * 208 + kc * 16; }
  const int vrow = tid >> 3, vch = tid & 7;
  const int nkt = L >> 6;
#pragma unroll
  for (int i = 0; i < 3; ++i) rk[i] = *(const u32x4*)(Kh + kgo[i]);
#pragma unroll
  for (int i = 0; i < 2; ++i) rv[i] = *(const u32x4*)(Vh + (size_t)(vrow + 32 * i) * MT + vch * 8);
  for (int kt = 0; kt < nkt; ++kt) {
    char* sk = smem + (kt & 1) * 22016;
    char* sv = sk + 13312;
#pragma unroll
    for (int i = 0; i < 3; ++i) *(u32x4*)(sk + klo[i]) = rk[i];
#pragma unroll
    for (int i = 0; i < 2; ++i) {
      char* d = sv + (vrow + 32 * i) * 136 + vch * 16;
      *(u32x2*)d = (u32x2){rv[i].x, rv[i].y};
      *(u32x2*)(d + 8) = (u32x2){rv[i].z, rv[i].w};
    }
    __syncthreads();
    if (kt + 1 < nkt) {
      const int key0 = (kt + 1) * 64;
#pragma unroll
      for (int i = 0; i < 3; ++i) rk[i] = *(const u32x4*)(Kh + (size_t)key0 * 96 + kgo[i]);
#pragma unroll
      for (int i = 0; i < 2; ++i) rv[i] = *(const u32x4*)(Vh + (size_t)(vrow + 32 * i) * MT + key0 + vch * 8);
    }
    f32x16 S[2];
#pragma unroll
    for (int kb = 0; kb < 2; ++kb) {
#pragma unroll
      for (int ks = 0; ks < 6; ++ks) {
        const bf16x8 kf = *(const bf16x8*)(sk + (kb * 32 + r) * 208 + (ks * 2 + h) * 16);
        S[kb] = __builtin_amdgcn_mfma_f32_32x32x16_bf16(kf, qf[ks], ks == 0 ? negm : S[kb], 0, 0, 0);
      }
    }
    float mx = fmaxf(fmaxf(S[0][0], S[0][1]), S[0][2]);
#pragma unroll
    for (int i = 3; i < 15; i += 2) mx = fmaxf(fmaxf(mx, S[0][i]), S[0][i + 1]);
    mx = fmaxf(mx, S[0][15]);
#pragma unroll
    for (int i = 0; i < 16; i += 2) mx = fmaxf(fmaxf(mx, S[1][i]), S[1][i + 1]);
    if (kt == 0 || __any(mx > 8.f)) {
      const float mxf = fmaxf(mx, __shfl_xor(mx, 32));
      const float delta = kt == 0 ? mxf : fmaxf(mxf, 0.f);
      const float alpha = kt == 0 ? 1.f : __builtin_amdgcn_exp2f(-delta);
      l *= alpha;
      const float nm = negm[0] - delta;
#pragma unroll
      for (int i = 0; i < 16; ++i) { O[0][i] *= alpha; O[1][i] *= alpha; S[0][i] -= delta; S[1][i] -= delta; negm[i] = nm; }
    }
    float ps = 0.f;
#pragma unroll
    for (int kb = 0; kb < 2; ++kb)
#pragma unroll
      for (int i = 0; i < 16; ++i) { S[kb][i] = __builtin_amdgcn_exp2f(S[kb][i]); ps += S[kb][i]; }
    l += ps;
    bf16x8 pf[2][2];
#pragma unroll
    for (int kb = 0; kb < 2; ++kb)
#pragma unroll
      for (int s = 0; s < 2; ++s) {
        u32x4 w;
        w.x = pk2(S[kb][8 * s + 0], S[kb][8 * s + 1]); w.y = pk2(S[kb][8 * s + 2], S[kb][8 * s + 3]);
        w.z = pk2(S[kb][8 * s + 4], S[kb][8 * s + 5]); w.w = pk2(S[kb][8 * s + 6], S[kb][8 * s + 7]);
        pf[kb][s] = __builtin_bit_cast(bf16x8, w);
      }
#pragma unroll
    for (int db = 0; db < 2; ++db)
#pragma unroll
      for (int kb = 0; kb < 2; ++kb)
#pragma unroll
        for (int s = 0; s < 2; ++s) {
          const char* a = sv + (db * 32 + r) * 136 + (kb * 32 + s * 16 + h * 4) * 2;
          const u32x2 lo = *(const u32x2*)a, hi = *(const u32x2*)(a + 16);
          const u32x4 w = {lo.x, lo.y, hi.x, hi.y};
          O[db] = __builtin_amdgcn_mfma_f32_32x32x16_bf16(__builtin_bit_cast(bf16x8, w), pf[kb][s], O[db], 0, 0, 0);
        }
  }
  __syncthreads();
  l += __shfl_xor(l, 32);
  const float inv = 1.f / l;
#pragma unroll
  for (int db = 0; db < 2; ++db)
#pragma unroll
    for (int g4 = 0; g4 < 4; ++g4) {
      const size_t o = (size_t)qtok * 512 + head * 64 + db * 32 + 8 * g4 + 4 * h;
      const u32x2 gz = *(const u32x2*)(SZA + o);
      const float g0 = __uint_as_float(gz.x << 16), g1 = __uint_as_float(gz.x & 0xffff0000u), g2 = __uint_as_float(gz.y << 16), g3 = __uint_as_float(gz.y & 0xffff0000u);
      u32x2 w;
      w.x = pk2(O[db][4 * g4 + 0] * inv * g0, O[db][4 * g4 + 1] * inv * g1);
      w.y = pk2(O[db][4 * g4 + 2] * inv * g2, O[db][4 * g4 + 3] * inv * g3);
#ifdef PROBE_NO_ATTN
      w.x = 0; w.y = 0;
#endif
      *(u32x2*)(YA + o) = w;
    }
}

DI void ph_mix(const Params& P, char* smem) {
  const bf16_t* U = (const bf16_t*)(P.ws + OFF_U);
  const bf16_t* HST = (const bf16_t*)(P.ws + OFF_HST);
  bf16_t* Y = (bf16_t*)(P.ws + OFF_S);
  const int NU = 2048 + 4096;
  for (int u = blockIdx.x; u < NU; u += gridDim.x) {
    if (u < 2048) {
      const int nt = u & 3, mt = (u >> 2) & 15, g = u >> 6, m0 = mt * 128, n0 = nt * 128;
      f32x16 acc[2][2];
      gemm_main1<ATwo, false>(acc, ATwo{U + (size_t)g * MT * 16, 512, 64, HST + (size_t)g * NCH * 256, 256}, m0,
                             (const bf16_t*)(P.ws + OFF_WOUT) + (size_t)g * 512 * 768, 768, n0, 768, smem);
      float* st = (float*)smem;
      stage_acc(acc, st);
      EPI8_BEGIN(st, 8, 4)
#pragma unroll
        for (int j = 0; j < 8; ++j) v[j] = geluf_(v[j]);
        st8bf(Y + ((size_t)g * NCH + m0 + lrow) * 512 + n0 + lc0, v);
      EPI8_END
    } else {
      const int v2 = u - 2048;
      const int head = v2 & 7, w = v2 >> 3;
      int tok0, L, qb;
      if (w < 256) { const int seq = w >> 7; qb = w & 127; tok0 = seq * 16384; L = 16384; }
      else { const int w2 = w - 256; const int seq = w2 >> 6; qb = w2 & 63; tok0 = 32768 + seq * 8192; L = 8192; }
#ifdef PROBE_ATTN_TWICE
#pragma unroll 1
      for (int rep_ = 0; rep_ < 2; ++rep_)
#endif
      attn_unit(P, tok0, L, head, qb * 128, smem);
    }
  }
}

DI void ph_glu(const Params& P, char* smem) {
  const bf16_t* Y = (const bf16_t*)(P.ws + OFF_S);
  const bf16_t* SZS = (const bf16_t*)(P.ws + OFF_SZS);
  bf16_t* YS = (bf16_t*)(P.ws + OFF_U);
  for (int u = blockIdx.x; u < 2048; u += gridDim.x) {
    const int nt = u & 3, mt = u >> 2, m0 = mt * 128, n0 = nt * 128;
    f32x16 acc[2][2];
    gemm_main<AGrp, false>(acc, AGrp{Y}, m0, (const bf16_t*)(P.ws + OFF_WGLU), 512, n0, 512, smem);
    float* st = (float*)smem;
    stage_acc(acc, st);
    EPI8_BEGIN(st, 8, 4)
      const int col = n0 + lc0, tok = m0 + lrow;
      float y[8], z[8], o[8];
      ld8bf(Y + ((size_t)(col >> 4) * MT + tok) * 16 + (col & 15), y);
      ld8bf(SZS + (size_t)tok * 512 + col, z);
#pragma unroll
      for (int j = 0; j < 8; ++j) o[j] = y[j] * sigmoidf_(v[j] + P.b_glu[col + j]) * z[j];
      st8bf(YS + (size_t)tok * 512 + col, o);
    EPI8_END
  }
}

DI void ph_merge(const Params& P, char* smem) {
  const bf16_t* YS = (const bf16_t*)(P.ws + OFF_U);
  const bf16_t* YA = (const bf16_t*)(P.ws + OFF_YA);
  const bf16_t* SGS = (const bf16_t*)(P.ws + OFF_SGS);
  const bf16_t* SGA = (const bf16_t*)(P.ws + OFF_SGA);
  bf16_t* MG = (bf16_t*)(P.ws + OFF_X0);
  for (int u = blockIdx.x; u < 4096; u += gridDim.x) {
    const int nt = u & 7, mt = u >> 3, m0 = mt * 128, n0 = nt * 128;
    f32x16 acc[2][2];
    float* st = (float*)smem;
#pragma unroll 1
    for (int pass = 0; pass < 2; ++pass) {
      const bf16_t* A = pass ? YA : YS;
      const bf16_t* B = (const bf16_t*)(P.ws + (pass ? OFF_WBA : OFF_WBS));
      const bf16_t* G = pass ? SGA : SGS;
      gemm_main<ARow, false>(acc, ARow{A, 512}, m0, B, 512, n0, 512, smem);
      stage_acc(acc, st);
      EPI8_BEGIN(st, 8, 4)
        const size_t o = (size_t)(m0 + lrow) * 1024 + n0 + lc0;
        float gte[8]; ld8bf(G + o, gte);
#pragma unroll
        for (int j = 0; j < 8; ++j) v[j] *= gte[j];
        if (pass) {
          float pr[8]; ld8bf(MG + o, pr);
#pragma unroll
          for (int j = 0; j < 8; ++j) v[j] += pr[j];
        }
        st8bf(MG + o, v);
      EPI8_END
    }
  }
}

DI void ph_out(const Params& P, char* smem) {
  const bf16_t* MG = (const bf16_t*)(P.ws + OFF_X0);
  const float2* STATS = (const float2*)(P.ws + OFF_STATS);
  for (int u = blockIdx.x; u < 4096; u += gridDim.x) {
    const int nt = u & 7, mt = u >> 3, m0 = mt * 128, n0 = nt * 128;
    f32x16 acc[2][2];
    gemm_main<ARow, false>(acc, ARow{MG, 1024}, m0, (const bf16_t*)(P.ws + OFF_WO), 1024, n0, 1024, smem);
    float* st = (float*)smem;
    stage_acc(acc, st);
    EPI8_BEGIN(st, 8, 4)
      const int tok = m0 + lrow, col = n0 + lc0;
      const float* xp = tok < 32768 ? P.x_prompt + (size_t)tok * DM + col : P.x_sample + (size_t)(tok - 32768) * DM + col;
      float xv[8], gg[8], bb[8];
      ld8(xp, xv); ld8(P.ln_in_g + col, gg); ld8(P.ln_in_b + col, bb);
      const float2 stt = STATS[tok];
#pragma unroll
      for (int j = 0; j < 8; ++j) v[j] += ALPHA_RES * ((xv[j] - stt.x) * stt.y * gg[j] + bb[j]);
      float* d = P.out + (size_t)tok * DM + col;
      *(float4*)d = make_float4(v[0], v[1], v[2], v[3]); *(float4*)(d + 4) = make_float4(v[4], v[5], v[6], v[7]);
    EPI8_END
  }
}

DI void ph_final_ln(const Params& P) {
  const int gt = blockIdx.x * blockDim.x + threadIdx.x, gs = gridDim.x * blockDim.x;
  const int lane = threadIdx.x & 63, gw = gt >> 6, nw = gs >> 6;
  for (int row = gw; row < MT; row += nw) {
    float* zr = P.out + (size_t)row * DM;
    float4 v[4];
    float s = 0.f;
#pragma unroll
    for (int i = 0; i < 4; ++i) { v[i] = *(const float4*)(zr + i * 256 + lane * 4); s += (v[i].x + v[i].y) + (v[i].z + v[i].w); }
#pragma unroll
    for (int o = 32; o >= 1; o >>= 1) s += __shfl_xor(s, o);
    const float mu = s * (1.f / 1024.f);
    float q = 0.f;
#pragma unroll
    for (int i = 0; i < 4; ++i) { const float a = v[i].x - mu, b = v[i].y - mu, c = v[i].z - mu, d = v[i].w - mu; q += (a * a + b * b) + (c * c + d * d); }
#pragma unroll
    for (int o = 32; o >= 1; o >>= 1) q += __shfl_xor(q, o);
    const float rstd = rsqrtf(q * (1.f / 1024.f) + 1e-5f);
#pragma unroll
    for (int i = 0; i < 4; ++i) {
      const int c = i * 256 + lane * 4;
      const float4 g = *(const float4*)(P.ln_g + c), b = *(const float4*)(P.ln_b + c);
      float4 o;
      o.x = (v[i].x - mu) * rstd * g.x + b.x; o.y = (v[i].y - mu) * rstd * g.y + b.y;
      o.z = (v[i].z - mu) * rstd * g.z + b.z; o.w = (v[i].w - mu) * rstd * g.w + b.w;
      *(float4*)(zr + c) = o;
    }
  }
}

#ifndef N_LAUNCH_MODE
#define N_LAUNCH_MODE 1
#endif

template <int PH> DI void run_phase(const Params& P, char* smem) {
  if (PH == 0) ph_tables(P);
  else if (PH == 1) ph_prep(P, smem);
  else if (PH == 2) ph_g1(P, smem);
  else if (PH == 3) ph_qkv(P, smem);
  else if (PH == 4) ph_scan(P);
  else if (PH == 5) ph_mix(P, smem);
  else if (PH == 6) ph_glu(P, smem);
  else if (PH == 7) ph_merge(P, smem);
  else if (PH == 8) ph_out(P, smem);
  else ph_final_ln(P);
}

#if N_LAUNCH_MODE == 1
__global__ void __launch_bounds__(256, 2) fwd_kernel(Params P_arg) {
  __shared__ __attribute__((aligned(16))) char smem[OFF_RSS + 512];
  cg::grid_group grid = cg::this_grid();
  const Params& P = *(const Params*)__builtin_amdgcn_kernarg_segment_ptr();
#if defined(REP_PHASE) && REP_PHASE == 0
  _Pragma("unroll 1") for (int rep_ = 0; rep_ < 2; ++rep_)
#endif
  run_phase<0>(P, smem); grid.sync();
#if defined(REP_PHASE) && REP_PHASE == 1
  _Pragma("unroll 1") for (int rep_ = 0; rep_ < 2; ++rep_)
#endif
  run_phase<1>(P, smem); grid.sync();
#if defined(REP_PHASE) && REP_PHASE == 2
  _Pragma("unroll 1") for (int rep_ = 0; rep_ < 2; ++rep_)
#endif
  run_phase<2>(P, smem); grid.sync();
#if defined(REP_PHASE) && REP_PHASE == 3
  _Pragma("unroll 1") for (int rep_ = 0; rep_ < 2; ++rep_)
#endif
  run_phase<3>(P, smem); grid.sync();
#if defined(REP_PHASE) && REP_PHASE == 4
  _Pragma("unroll 1") for (int rep_ = 0; rep_ < 2; ++rep_)
#endif
  run_phase<4>(P, smem); grid.sync();
#if defined(REP_PHASE) && REP_PHASE == 5
  _Pragma("unroll 1") for (int rep_ = 0; rep_ < 2; ++rep_)
#endif
  run_phase<5>(P, smem); grid.sync();
#if defined(REP_PHASE) && REP_PHASE == 6
  _Pragma("unroll 1") for (int rep_ = 0; rep_ < 2; ++rep_)
#endif
  run_phase<6>(P, smem); grid.sync();
#if defined(REP_PHASE) && REP_PHASE == 7
  _Pragma("unroll 1") for (int rep_ = 0; rep_ < 2; ++rep_)
#endif
  run_phase<7>(P, smem); grid.sync();
#if defined(REP_PHASE) && REP_PHASE == 8
  _Pragma("unroll 1") for (int rep_ = 0; rep_ < 2; ++rep_)
#endif
  run_phase<8>(P, smem); grid.sync();
#if defined(REP_PHASE) && REP_PHASE == 9
  _Pragma("unroll 1") for (int rep_ = 0; rep_ < 2; ++rep_)
#endif
  run_phase<9>(P, smem);
}
#else
template <int PH> __global__ void __launch_bounds__(256, 2) phase_kernel(Params P) {
  __shared__ __attribute__((aligned(16))) char smem[OFF_RSS + 512];
  run_phase<PH>(P, smem);
}
#endif

extern "C" void kernel_launch(void* const* d_in, const int* in_sizes, int n_in, void* d_out, int out_size, void* d_ws, size_t ws_size, hipStream_t stream) {
  if (ws_size < WS_NEEDED) { fprintf(stderr, "workspace too small: %zu < %zu\n", ws_size, WS_NEEDED); return; }
  Params p{};
  const float** f = (const float**)&p;
  for (int i = 0; i < 29; ++i) f[i] = (const float*)d_in[i];
  p.out = (float*)d_out;
  p.ws = (char*)d_ws;
  static int grid_blocks = 0;
#if N_LAUNCH_MODE == 1
  if (!grid_blocks) {
    int dev = 0, cus = 0, per_cu = 0;
    (void)hipGetDevice(&dev);
    (void)hipDeviceGetAttribute(&cus, hipDeviceAttributeMultiprocessorCount, dev);
    (void)hipOccupancyMaxActiveBlocksPerMultiprocessor(&per_cu, fwd_kernel, 256, 0);
    if (per_cu > 2) per_cu = 2;
    if (per_cu < 1) per_cu = 1;
    grid_blocks = cus * per_cu;
  }
  void* args[] = {&p};
  hipError_t e = hipLaunchCooperativeKernel((void*)fwd_kernel, dim3(grid_blocks), dim3(256), args, 0, stream);
  if (e != hipSuccess) fprintf(stderr, "cooperative launch failed: %s (grid %d)\n", hipGetErrorString(e), grid_blocks);
#else
  grid_blocks = 512;
  hipLaunchKernelGGL(phase_kernel<0>, dim3(grid_blocks), dim3(256), 0, stream, p);
  hipLaunchKernelGGL(phase_kernel<1>, dim3(grid_blocks), dim3(256), 0, stream, p);
  hipLaunchKernelGGL(phase_kernel<2>, dim3(grid_blocks), dim3(256), 0, stream, p);
  hipLaunchKernelGGL(phase_kernel<3>, dim3(grid_blocks), dim3(256), 0, stream, p);
  hipLaunchKernelGGL(phase_kernel<4>, dim3(grid_blocks), dim3(256), 0, stream, p);
  hipLaunchKernelGGL(phase_kernel<5>, dim3(grid_blocks), dim3(256), 0, stream, p);
  hipLaunchKernelGGL(phase_kernel<6>, dim3(grid_blocks), dim3(256), 0, stream, p);
  hipLaunchKernelGGL(phase_kernel<7>, dim3(grid_blocks), dim3(256), 0, stream, p);
  hipLaunchKernelGGL(phase_kernel<8>, dim3(grid_blocks), dim3(256), 0, stream, p);
  hipLaunchKernelGGL(phase_kernel<9>, dim3(grid_blocks), dim3(256), 0, stream, p);
#endif
}
```

```cpp
#include <hip/hip_runtime.h>
#include <hip/hip_cooperative_groups.h>
#include <cstdint>
#include <cstdio>
namespace cg = cooperative_groups;

#define DI __device__ __forceinline__
typedef unsigned short bf16_t;
typedef short bf16x8 __attribute__((ext_vector_type(8)));
typedef float f32x16 __attribute__((ext_vector_type(16)));
typedef unsigned u32x4 __attribute__((ext_vector_type(4)));
typedef unsigned u32x2 __attribute__((ext_vector_type(2)));

constexpr int MT = 65536;
constexpr int DM = 1024;
constexpr int TCH = 32;
constexpr int NCH = MT / TCH;
constexpr size_t MiB = (size_t)1 << 20;

constexpr size_t OFF_X0 = 0;
constexpr size_t OFF_S = 0;
constexpr size_t OFF_HST = 64 * MiB;
constexpr size_t OFF_U = 128 * MiB;
constexpr size_t OFF_SZS = 192 * MiB;
constexpr size_t OFF_SZA = 256 * MiB;
constexpr size_t OFF_SGS = 320 * MiB;
constexpr size_t OFF_SGA = 448 * MiB;
constexpr size_t OFF_CQ = 576 * MiB;
constexpr size_t OFF_CKV = 608 * MiB;
constexpr size_t OFF_KR = 624 * MiB;
constexpr size_t OFF_YA = 628 * MiB;
constexpr size_t OFF_W1T = 692 * MiB;
constexpr size_t OFF_WUQ = 700 * MiB;
constexpr size_t OFF_WUKV = OFF_WUQ + MiB / 2;
constexpr size_t OFF_WGLU = OFF_WUKV + MiB / 2;
constexpr size_t OFF_WBS = OFF_WGLU + MiB / 2;
constexpr size_t OFF_WBA = OFF_WBS + MiB;
constexpr size_t OFF_WO = OFF_WBA + MiB;
constexpr size_t OFF_WST = OFF_WO + 2 * MiB;
constexpr size_t OFF_WOUT = OFF_WST + 8 * MiB;
constexpr size_t OFF_LP = OFF_WOUT + 24 * MiB;
constexpr size_t OFF_BT = OFF_LP + 2 * MiB;
constexpr size_t OFF_KT = OFF_BT + MiB;
constexpr size_t OFF_ROPE = OFF_KT + 2 * MiB;
constexpr size_t OFF_STATS = OFF_ROPE + 2 * MiB;
constexpr size_t WS_NEEDED = OFF_STATS + MiB;
constexpr size_t OFF_Q = 0;
constexpr size_t OFF_K = 96 * MiB;
constexpr size_t OFF_VT = 192 * MiB;

constexpr float ALPHA_RES = 1.18920711500272f;
constexpr float QSCALE = 0.14724444f;

struct Params {
  const float *x_prompt, *x_sample, *ln_in_g, *ln_in_b, *w_in, *b_re, *b_im, *a_re_f, *a_im_f, *ldt_f, *c_re_f, *c_im_f, *a_re_b, *a_im_b,
      *ldt_b, *c_re_b, *c_im_b, *ssm_d, *w_glu, *b_glu, *q_norm_g, *w_uq, *kv_norm_g, *w_ukv, *w_bs, *w_ba, *w_o, *ln_g, *ln_b;
  float* out;
  char* ws;
  int pad0, pad1;
};

DI bf16_t f2bf(float x) { unsigned u = __float_as_uint(x); u += 0x7fffu + ((u >> 16) & 1u); return (bf16_t)(u >> 16); }
DI unsigned pk2(float lo, float hi) { unsigned r; asm("v_cvt_pk_bf16_f32 %0, %1, %2" : "=v"(r) : "v"(lo), "v"(hi)); return r; }
DI float bf2f(bf16_t b) { return __uint_as_float(((unsigned)b) << 16); }
DI float sigmoidf_(float x) { return __builtin_amdgcn_rcpf(1.f + __expf(-x)); }
DI float siluf_(float x) { return x * sigmoidf_(x); }
DI float geluf_(float x) { return x * sigmoidf_(1.5957691216057308f * (x + 0.044715f * x * x * x)); }
DI int crow(int i, int h) { return (i & 3) + 8 * (i >> 2) + 4 * h; }
DI int tok_pos(int t) { return t < 32768 ? (t & 16383) : (t & 8191); }

DI void sincos2pi(double rev, double& s, double& c) {
  rev -= rint(rev);
  double q = rint(rev * 4.0);
  double y = (rev - q * 0.25) * 6.283185307179586476925;
  double y2 = y * y;
  double sp = y * (1.0 + y2 * (-1.0 / 6 + y2 * (1.0 / 120 + y2 * (-1.0 / 5040 + y2 * (1.0 / 362880 + y2 * (-1.0 / 39916800 + y2 * (1.0 / 6227020800.0)))))));
  double cp = 1.0 + y2 * (-0.5 + y2 * (1.0 / 24 + y2 * (-1.0 / 720 + y2 * (1.0 / 40320 + y2 * (-1.0 / 3628800 + y2 * (1.0 / 479001600.0 + y2 * (-1.0 / 87178291200.0)))))));
  int qi = ((int)q) & 3;
  if (qi == 0) { s = sp; c = cp; } else if (qi == 1) { s = cp; c = -sp; } else if (qi == 2) { s = -sp; c = -cp; } else { s = -cp; c = sp; }
}

struct ARow { const bf16_t* p; int ld; DI const bf16_t* operator()(int row, int kc) const { return p + (size_t)row * ld + kc * 8; } };
struct ATwo { const bf16_t* p1; int ld1; int kc1; const bf16_t* p2; int ld2;
  DI const bf16_t* operator()(int row, int kc) const { return kc < kc1 ? p1 + (size_t)row * ld1 + kc * 8 : p2 + (size_t)row * ld2 + (kc - kc1) * 8; } };
struct AGrp { const bf16_t* p; DI const bf16_t* operator()(int row, int kc) const { return p + ((size_t)(kc >> 1) * MT + row) * 16 + (kc & 1) * 8; } };

constexpr int STL = 132;
constexpr int OFF_RSS = 128 * STL * 4;
DI int swz(int row, int c) { return row * 128 + ((c ^ ((row >> 1) & 7)) << 4); }

template <class AL, bool ROWSS>
DI void gemm_main1(f32x16 (&acc)[2][2], const AL& al, int m0, const bf16_t* __restrict__ Bt, int ldb, int n0, int K, char* smem) {
  const int tid = threadIdx.x, lane = tid & 63, wave = tid >> 6, wm = wave >> 1, wn = wave & 1, r = lane & 31, h = lane >> 5;
  const int srow = tid >> 3, sch = tid & 7;
  u32x4 ra[4], rb[4];
  float ss[4] = {0.f, 0.f, 0.f, 0.f};
  const int nk = K >> 6;
#pragma unroll
  for (int mi = 0; mi < 2; ++mi)
#pragma unroll
    for (int ni = 0; ni < 2; ++ni)
#pragma unroll
      for (int i = 0; i < 16; ++i) acc[mi][ni][i] = 0.f;
#pragma unroll
  for (int i = 0; i < 4; ++i) {
    ra[i] = *(const u32x4*)al(m0 + srow + 32 * i, sch);
    rb[i] = *(const u32x4*)(Bt + (size_t)(n0 + srow + 32 * i) * ldb + sch * 8);
  }
  for (int kt = 0; kt < nk; ++kt) {
    char* sa = smem + (kt & 1) * 32768;
    char* sb = sa + 16384;
#pragma unroll
    for (int i = 0; i < 4; ++i) {
      const int off = swz(srow + 32 * i, sch);
      *(u32x4*)(sa + off) = ra[i];
      *(u32x4*)(sb + off) = rb[i];
      if (ROWSS) {
#pragma unroll
        for (int j = 0; j < 4; ++j) { float lo = __uint_as_float(ra[i][j] << 16), hi = __uint_as_float(ra[i][j] & 0xffff0000u); ss[i] += lo * lo + hi * hi; }
      }
    }
    __syncthreads();
    if (kt + 1 < nk) {
#pragma unroll
      for (int i = 0; i < 4; ++i) {
        ra[i] = *(const u32x4*)al(m0 + srow + 32 * i, (kt + 1) * 8 + sch);
        rb[i] = *(const u32x4*)(Bt + (size_t)(n0 + srow + 32 * i) * ldb + (kt + 1) * 64 + sch * 8);
      }
    }
#pragma unroll
    for (int ks = 0; ks < 4; ++ks) {
      bf16x8 af[2], bfr[2];
#pragma unroll
      for (int mi = 0; mi < 2; ++mi) af[mi] = *(const bf16x8*)(sa + swz(wm * 64 + mi * 32 + r, ks * 2 + h));
#pragma unroll
      for (int ni = 0; ni < 2; ++ni) bfr[ni] = *(const bf16x8*)(sb + swz(wn * 64 + ni * 32 + r, ks * 2 + h));
#pragma unroll
      for (int mi = 0; mi < 2; ++mi)
#pragma unroll
        for (int ni = 0; ni < 2; ++ni) acc[mi][ni] = __builtin_amdgcn_mfma_f32_32x32x16_bf16(af[mi], bfr[ni], acc[mi][ni], 0, 0, 0);
    }
  }
  __syncthreads();
  if (ROWSS) {
    float* rss = (float*)(smem + OFF_RSS);
#pragma unroll
    for (int i = 0; i < 4; ++i) {
      float v = ss[i];
      v += __shfl_xor(v, 1); v += __shfl_xor(v, 2); v += __shfl_xor(v, 4);
      if (sch == 0) rss[srow + 32 * i] = v;
    }
    __syncthreads();
  }
}

template <class AL, bool ROWSS>
DI void gemm_main(f32x16 (&acc)[2][2], const AL& al, int m0, const bf16_t* __restrict__ Bt, int ldb, int n0, int K, char* smem) {
  const int tid = threadIdx.x, lane = tid & 63, wave = tid >> 6, wm = wave >> 1, wn = wave & 1, r = lane & 31, h = lane >> 5;
  const int srow = tid >> 3, sch = tid & 7;
  u32x4 ra[3][4], rb[3][4];
  float ss[4] = {0.f, 0.f, 0.f, 0.f};
  const int nk = K >> 6;
#pragma unroll
  for (int mi = 0; mi < 2; ++mi)
#pragma unroll
    for (int ni = 0; ni < 2; ++ni)
#pragma unroll
      for (int i = 0; i < 16; ++i) acc[mi][ni][i] = 0.f;
#define GLOAD(SET, KT)                                                                                   \
  _Pragma("unroll") for (int i = 0; i < 4; ++i) {                                                        \
    ra[SET][i] = *(const u32x4*)al(m0 + srow + 32 * i, (KT) * 8 + sch);                                  \
    rb[SET][i] = *(const u32x4*)(Bt + (size_t)(n0 + srow + 32 * i) * ldb + (KT) * 64 + sch * 8);         \
  }
  GLOAD(0, 0)
  if (1 < nk) { GLOAD(1, 1) }
  if (2 < nk) { GLOAD(2, 2) }
#define GSTEP(SET, KT)                                                                                   \
  if ((KT) < nk) {                                                                                       \
    char* sa = smem + ((KT) & 1) * 32768;                                                                \
    char* sb = sa + 16384;                                                                               \
    _Pragma("unroll") for (int i = 0; i < 4; ++i) {                                                      \
      const int off = swz(srow + 32 * i, sch);                                                           \
      *(u32x4*)(sa + off) = ra[SET][i];                                                                  \
      *(u32x4*)(sb + off) = rb[SET][i];                                                                  \
      if (ROWSS) {                                                                                       \
        _Pragma("unroll") for (int j = 0; j < 4; ++j) {                                                  \
          const float lo = __uint_as_float(ra[SET][i][j] << 16), hi = __uint_as_float(ra[SET][i][j] & 0xffff0000u); \
          ss[i] += lo * lo + hi * hi; }                                                                  \
      }                                                                                                  \
    }                                                                                                    \
    __syncthreads();                                                                                     \
    if ((KT) + 3 < nk) { GLOAD(SET, (KT) + 3) }                                                          \
    _Pragma("unroll") for (int ks = 0; ks < 4; ++ks) {                                                   \
      bf16x8 af[2], bfr[2];                                                                              \
      _Pragma("unroll") for (int mi = 0; mi < 2; ++mi) af[mi] = *(const bf16x8*)(sa + swz(wm * 64 + mi * 32 + r, ks * 2 + h)); \
      _Pragma("unroll") for (int ni = 0; ni < 2; ++ni) bfr[ni] = *(const bf16x8*)(sb + swz(wn * 64 + ni * 32 + r, ks * 2 + h)); \
      _Pragma("unroll") for (int mi = 0; mi < 2; ++mi)                                                   \
        _Pragma("unroll") for (int ni = 0; ni < 2; ++ni) acc[mi][ni] = __builtin_amdgcn_mfma_f32_32x32x16_bf16(af[mi], bfr[ni], acc[mi][ni], 0, 0, 0); \
    }                                                                                                    \
  }
  for (int kt = 0; kt < nk; kt += 3) {
    GSTEP(0, kt)
    GSTEP(1, kt + 1)
    GSTEP(2, kt + 2)
  }
#undef GSTEP
#undef GLOAD
  __syncthreads();
  if (ROWSS) {
    float* rss = (float*)(smem + OFF_RSS);
#pragma unroll
    for (int i = 0; i < 4; ++i) {
      float v = ss[i];
      v += __shfl_xor(v, 1); v += __shfl_xor(v, 2); v += __shfl_xor(v, 4);
      if (sch == 0) rss[srow + 32 * i] = v;
    }
    __syncthreads();
  }
}

DI void stage_acc(const f32x16 (&acc)[2][2], float* st) {
  const int lane = threadIdx.x & 63, wave = threadIdx.x >> 6, wm = wave >> 1, wn = wave & 1, r = lane & 31, h = lane >> 5;
#pragma unroll
  for (int mi = 0; mi < 2; ++mi)
#pragma unroll
    for (int ni = 0; ni < 2; ++ni)
#pragma unroll
      for (int i = 0; i < 16; ++i) st[(wm * 64 + mi * 32 + crow(i, h)) * STL + wn * 64 + ni * 32 + r] = acc[mi][ni][i];
  __syncthreads();
}
DI void ld8(const float* st, float (&v)[8]) { const float4 a = *(const float4*)st, b = *(const float4*)(st + 4); v[0] = a.x; v[1] = a.y; v[2] = a.z; v[3] = a.w; v[4] = b.x; v[5] = b.y; v[6] = b.z; v[7] = b.w; }
DI void ld8bf(const bf16_t* p, float (&v)[8]) {
  const u32x4 w = *(const u32x4*)p;
#pragma unroll
  for (int j = 0; j < 4; ++j) { v[2 * j] = __uint_as_float(w[j] << 16); v[2 * j + 1] = __uint_as_float(w[j] & 0xffff0000u); }
}
DI void st8bf(bf16_t* p, const float (&v)[8]) { u32x4 w; w.x = pk2(v[0], v[1]); w.y = pk2(v[2], v[3]); w.z = pk2(v[4], v[5]); w.w = pk2(v[6], v[7]); *(u32x4*)p = w; }
#define EPI8_BEGIN(st, NIT, CSH)                                              \
  _Pragma("unroll 1") for (int it_ = 0; it_ < (NIT); ++it_) {                   \
    const int gid_ = it_ * 256 + threadIdx.x; const int lrow = gid_ >> (CSH), lc0 = (gid_ & ((1 << (CSH)) - 1)) * 8; \
    float v[8]; ld8((st) + lrow * STL + lc0, v);
#define EPI8_END } __syncthreads();

DI void ph_tables(const Params& P) {
  const int gt = blockIdx.x * blockDim.x + threadIdx.x, gs = gridDim.x * blockDim.x;
  float2* LP = (float2*)(P.ws + OFF_LP);
  float2* BT = (float2*)(P.ws + OFF_BT);
  float2* ROPE = (float2*)(P.ws + OFF_ROPE);
  for (int idx = gt; idx < 32 * 2 * 64; idx += gs) {
    const int n = idx & 63, dir = (idx >> 6) & 1, g = idx >> 7;
    const double are = dir ? (double)P.a_re_b[g * 64 + n] : (double)P.a_re_f[g * 64 + n];
    const double aim = dir ? (double)P.a_im_b[g * 64 + n] : (double)P.a_im_f[g * 64 + n];
    const double dt = exp(dir ? (double)P.ldt_b[g] : (double)P.ldt_f[g]);
    double l1r = 1.0, l1i = 0.0;
    for (int d = 0; d <= 32; ++d) {
      const double mag = exp(are * dt * d);
      double s, c; sincos2pi(aim * dt * d * 0.15915494309189533577, s, c);
      LP[((g * 2 + dir) * 33 + d) * 64 + n] = make_float2((float)(mag * c), (float)(mag * s));
      if (d == 1) { l1r = mag * c; l1i = mag * s; }
    }
    const double zr = are * dt, zi = aim * dt;
    double cr, ci;
    if (zr * zr + zi * zi < 0.25) {
      double tr = 1.0, ti = 0.0, sr = 1.0, si = 0.0;
      for (int k = 1; k < 24; ++k) { const double nr = (tr * zr - ti * zi) / (k + 1), ni = (tr * zi + ti * zr) / (k + 1); tr = nr; ti = ni; sr += tr; si += ti; }
      cr = sr * dt; ci = si * dt;
    } else {
      const double nr = l1r - 1.0, ni = l1i, den = are * are + aim * aim;
      cr = (nr * are + ni * aim) / den; ci = (ni * are - nr * aim) / den;
    }
    for (int q = 0; q < 16; ++q) {
      const double br = P.b_re[(g * 64 + n) * 16 + q], bi = P.b_im[(g * 64 + n) * 16 + q];
      BT[((g * 2 + dir) * 64 + n) * 16 + q] = make_float2((float)(br * cr - bi * ci), (float)(br * ci + bi * cr));
    }
  }
  for (int idx = gt; idx < 16384 * 16; idx += gs) {
    const int j = idx & 15, pos = idx >> 4;
    const double inv = exp(-(double)j * (9.210340371976182736 / 16.0));
    double s, c; sincos2pi((double)pos * inv * 0.15915494309189533577, s, c);
    ROPE[idx] = make_float2((float)c, (float)s);
  }
}

DI void transpose_tile(const float* __restrict__ src, int lds_, int K, bf16_t* __restrict__ dst, int k0, int n0, int mode, const float* __restrict__ rowscale, float* tile) {
  const int tid = threadIdx.x;
  {
    const int nn = tid & 63, n = n0 + nn;
    int sc = n;
    if (mode == 1) sc = n < 1440 ? n : (n < 1536 ? -1 : n - 96);
#pragma unroll 4
    for (int i = 0; i < 16; ++i) {
      const int kk = (tid >> 6) + 4 * i, k = k0 + kk;
      float v = sc >= 0 ? src[(size_t)k * lds_ + sc] : 0.f;
      if (rowscale) v *= rowscale[k];
      tile[kk * 65 + nn] = v;
    }
  }
  __syncthreads();
  {
    const int kk = tid & 63;
#pragma unroll 4
    for (int i = 0; i < 16; ++i) { const int nn = (tid >> 6) + 4 * i; dst[(size_t)(n0 + nn) * K + k0 + kk] = f2bf(tile[kk * 65 + nn]); }
  }
  __syncthreads();
}

DI void ph_prep(const Params& P, char* smem) {
  const int gt = blockIdx.x * blockDim.x + threadIdx.x, gs = gridDim.x * blockDim.x;
  const float2* LP = (const float2*)(P.ws + OFF_LP);
  const float2* BT = (const float2*)(P.ws + OFF_BT);
  float* KT = (float*)(P.ws + OFF_KT);
  bf16_t* WST = (bf16_t*)(P.ws + OFF_WST);
  bf16_t* WOUT = (bf16_t*)(P.ws + OFF_WOUT);
  for (int idx = gt; idx < 32 * 2 * 32 * 256; idx += gs) {
    const int q = idx & 15, p = (idx >> 4) & 15, d = (idx >> 8) & 31, dir = (idx >> 13) & 1, g = idx >> 14;
    const float* cre = (dir ? P.c_re_b : P.c_re_f) + (g * 16 + p) * 64;
    const float* cim = (dir ? P.c_im_b : P.c_im_f) + (g * 16 + p) * 64;
    const float2* lp = LP + ((g * 2 + dir) * 33 + d) * 64;
    const float2* bt = BT + ((g * 2 + dir) * 64) * 16 + q;
    float s = 0.f;
    for (int n = 0; n < 64; ++n) {
      const float2 l = lp[n], b = bt[n * 16];
      const float wr = l.x * b.x - l.y * b.y, wi = l.x * b.y + l.y * b.x;
      s += cre[n] * wr - cim[n] * wi;
    }
    KT[idx] = s;
  }
  for (int idx = gt; idx < 32 * 256 * 512; idx += gs) {
    const int k = idx & 511, np = (idx >> 9) & 255, g = idx >> 17;
    const int q = k & 15, s = k >> 4, n = np & 63, reim = (np >> 6) & 1, dir = np >> 7;
    const int e = dir ? s : (TCH - 1 - s);
    const float2 l = LP[((g * 2 + dir) * 33 + e) * 64 + n], b = BT[((g * 2 + dir) * 64 + n) * 16 + q];
    const float val = reim ? (l.x * b.y + l.y * b.x) : (l.x * b.x - l.y * b.y);
    WST[idx] = f2bf(val);
  }
  for (int idx = gt; idx < 32 * 512 * 256; idx += gs) {
    const int k2 = idx & 255, tp = (idx >> 8) & 511, g = idx >> 17;
    const int n = k2 & 63, reim = (k2 >> 6) & 1, dir = k2 >> 7, p = tp & 15, t = tp >> 4;
    const int e = dir ? (TCH - t) : (t + 1);
    const float2 l = LP[((g * 2 + dir) * 33 + e) * 64 + n];
    const float cr = (dir ? P.c_re_b : P.c_re_f)[(g * 16 + p) * 64 + n], ci = (dir ? P.c_im_b : P.c_im_f)[(g * 16 + p) * 64 + n];
    const float val = reim ? -(cr * l.y + ci * l.x) : (cr * l.x - ci * l.y);
#ifdef PROBE_NO_CONV
    WOUT[((size_t)g * 512 + tp) * 768 + 512 + k2] = 0;
#else
    WOUT[((size_t)g * 512 + tp) * 768 + 512 + k2] = f2bf(val);
#endif
  }
  {
    float* tile = (float*)smem;
    for (int u = blockIdx.x; u < 1680; u += gridDim.x) {
      if (u < 1024) transpose_tile(P.w_in, 4000, 1024, (bf16_t*)(P.ws + OFF_W1T), (u & 15) * 64, (u >> 4) * 64, 1, nullptr, tile);
      else if (u < 1072) { const int v = u - 1024; transpose_tile(P.w_uq, 768, 256, (bf16_t*)(P.ws + OFF_WUQ), (v & 3) * 64, (v >> 2) * 64, 0, P.q_norm_g, tile); }
      else if (u < 1104) { const int v = u - 1072; transpose_tile(P.w_ukv, 1024, 128, (bf16_t*)(P.ws + OFF_WUKV), (v & 1) * 64, (v >> 1) * 64, 0, P.kv_norm_g, tile); }
      else if (u < 1168) { const int v = u - 1104; transpose_tile(P.w_glu, 512, 512, (bf16_t*)(P.ws + OFF_WGLU), (v & 7) * 64, (v >> 3) * 64, 0, nullptr, tile); }
      else if (u < 1296) { const int v = u - 1168; transpose_tile(P.w_bs, 1024, 512, (bf16_t*)(P.ws + OFF_WBS), (v & 7) * 64, (v >> 3) * 64, 0, nullptr, tile); }
      else if (u < 1424) { const int v = u - 1296; transpose_tile(P.w_ba, 1024, 512, (bf16_t*)(P.ws + OFF_WBA), (v & 7) * 64, (v >> 3) * 64, 0, nullptr, tile); }
      else { const int v = u - 1424; transpose_tile(P.w_o, 1024, 1024, (bf16_t*)(P.ws + OFF_WO), (v & 15) * 64, (v >> 4) * 64, 0, nullptr, tile); }
    }
  }
  {
    bf16_t* X0 = (bf16_t*)(P.ws + OFF_X0);
    float2* STATS = (float2*)(P.ws + OFF_STATS);
    const int lane = threadIdx.x & 63, gw = gt >> 6, nw = gs >> 6;
    for (int row0 = gw * 4; row0 < MT; row0 += nw * 4) {
      float4 v[4][4];
#pragma unroll
      for (int rr = 0; rr < 4; ++rr) {
        const int row = row0 + rr;
        const float* xr = row < 32768 ? P.x_prompt + (size_t)row * DM : P.x_sample + (size_t)(row - 32768) * DM;
#pragma unroll
        for (int i = 0; i < 4; ++i) v[rr][i] = *(const float4*)(xr + i * 256 + lane * 4);
      }
#pragma unroll
      for (int rr = 0; rr < 4; ++rr) {
        const int row = row0 + rr;
        float s = 0.f;
#pragma unroll
        for (int i = 0; i < 4; ++i) s += (v[rr][i].x + v[rr][i].y) + (v[rr][i].z + v[rr][i].w);
#pragma unroll
        for (int o = 32; o >= 1; o >>= 1) s += __shfl_xor(s, o);
        const float mu = s * (1.f / 1024.f);
        float q = 0.f;
#pragma unroll
        for (int i = 0; i < 4; ++i) { const float a = v[rr][i].x - mu, b = v[rr][i].y - mu, c = v[rr][i].z - mu, d = v[rr][i].w - mu; q += (a * a + b * b) + (c * c + d * d); }
#pragma unroll
        for (int o = 32; o >= 1; o >>= 1) q += __shfl_xor(q, o);
        const float rstd = rsqrtf(q * (1.f / 1024.f) + 1e-5f);
        if (lane == 0) STATS[row] = make_float2(mu, rstd);
#pragma unroll
        for (int i = 0; i < 4; ++i) {
          const int c = i * 256 + lane * 4;
          const float4 g = *(const float4*)(P.ln_in_g + c), b = *(const float4*)(P.ln_in_b + c);
          u32x2 o;
          o.x = pk2((v[rr][i].x - mu) * rstd * g.x + b.x, (v[rr][i].y - mu) * rstd * g.y + b.y);
          o.y = pk2((v[rr][i].z - mu) * rstd * g.z + b.z, (v[rr][i].w - mu) * rstd * g.w + b.w);
          *(u32x2*)(X0 + (size_t)row * DM + c) = o;
        }
      }
    }
  }
}

DI void ph_g1(const Params& P, char* smem) {
  const int gt = blockIdx.x * blockDim.x + threadIdx.x, gs = gridDim.x * blockDim.x;
  {
    const float* KT = (const float*)(P.ws + OFF_KT);
    bf16_t* WOUT = (bf16_t*)(P.ws + OFF_WOUT);
    for (int idx = gt; idx < 32 * 512 * 512; idx += gs) {
      const int k = idx & 511, tp = (idx >> 9) & 511, g = idx >> 18;
      const int q = k & 15, s = k >> 4, p = tp & 15, t = tp >> 4;
      float val;
      if (s < t) val = KT[(((g * 2 + 0) * 32 + (t - s)) * 16 + p) * 16 + q];
      else if (s > t) val = KT[(((g * 2 + 1) * 32 + (s - t)) * 16 + p) * 16 + q];
      else val = KT[(((g * 2 + 0) * 32) * 16 + p) * 16 + q] + KT[(((g * 2 + 1) * 32) * 16 + p) * 16 + q] + (p == q ? P.ssm_d[g * 16 + p] : 0.f);
#ifdef PROBE_NO_CONV
      val = (s == t && p == q) ? P.ssm_d[g * 16 + p] : 0.f;
#endif
      WOUT[((size_t)g * 512 + tp) * 768 + k] = f2bf(val);
    }
  }
  const bf16_t* X0 = (const bf16_t*)(P.ws + OFF_X0);
  const bf16_t* W1T = (const bf16_t*)(P.ws + OFF_W1T);
  bf16_t* U = (bf16_t*)(P.ws + OFF_U);
  bf16_t* SZS = (bf16_t*)(P.ws + OFF_SZS);
  bf16_t* SZA = (bf16_t*)(P.ws + OFF_SZA);
  bf16_t* SGS = (bf16_t*)(P.ws + OFF_SGS);
  bf16_t* SGA = (bf16_t*)(P.ws + OFF_SGA);
  bf16_t* CQ = (bf16_t*)(P.ws + OFF_CQ);
  bf16_t* CKV = (bf16_t*)(P.ws + OFF_CKV);
  bf16_t* KR = (bf16_t*)(P.ws + OFF_KR);
  const float2* ROPE = (const float2*)(P.ws + OFF_ROPE);
  for (int tile = blockIdx.x; tile < 512 * 32; tile += gridDim.x) {
    const int nt = tile & 31, mt = tile >> 5, m0 = mt * 128, n0 = nt * 128;
    f32x16 acc[2][2];
    gemm_main<ARow, false>(acc, ARow{X0, 1024}, m0, W1T, 1024, n0, 1024, smem);
    float* st = (float*)smem;
    stage_acc(acc, st);
    if (nt < 4) {
      EPI8_BEGIN(st, 8, 4) const int col = n0 + lc0; st8bf(U + ((size_t)(col >> 4) * MT + m0 + lrow) * 16 + (col & 15), v); EPI8_END
    } else if (nt < 8) {
      EPI8_BEGIN(st, 8, 4)
#pragma unroll
        for (int j = 0; j < 8; ++j) v[j] = siluf_(v[j]);
        st8bf(SZS + (size_t)(m0 + lrow) * 512 + n0 - 512 + lc0, v);
      EPI8_END
    } else if (nt < 10) {
      EPI8_BEGIN(st, 8, 4) st8bf(CQ + (size_t)(m0 + lrow) * 256 + n0 - 1024 + lc0, v); EPI8_END
    } else if (nt == 10) {
      EPI8_BEGIN(st, 8, 4) st8bf(CKV + (size_t)(m0 + lrow) * 128 + lc0, v); EPI8_END
    } else if (nt == 11) {
      EPI8_BEGIN(st, 8, 4)
        if (lc0 < 32) {
          const int tok = m0 + lrow; const float2* cs = ROPE + tok_pos(tok) * 16 + (lc0 & 15);
          float pv[8]; ld8(st + lrow * STL + (lc0 ^ 16), pv);
          float o[8];
#pragma unroll
          for (int j = 0; j < 8; ++j) o[j] = lc0 < 16 ? v[j] * cs[j].x - pv[j] * cs[j].y : pv[j] * cs[j].y + v[j] * cs[j].x;
          st8bf(KR + (size_t)tok * 32 + lc0, o);
        }
      EPI8_END
    } else if (nt < 16) {
      EPI8_BEGIN(st, 8, 4)
#pragma unroll
        for (int j = 0; j < 8; ++j) v[j] = siluf_(v[j]);
        st8bf(SZA + (size_t)(m0 + lrow) * 512 + n0 - 1536 + lc0, v);
      EPI8_END
    } else if (nt < 24) {
      EPI8_BEGIN(st, 8, 4)
#pragma unroll
        for (int j = 0; j < 8; ++j) v[j] = sigmoidf_(v[j]);
        st8bf(SGS + (size_t)(m0 + lrow) * 1024 + n0 - 2048 + lc0, v);
      EPI8_END
    } else {
      EPI8_BEGIN(st, 8, 4)
#pragma unroll
        for (int j = 0; j < 8; ++j) v[j] = sigmoidf_(v[j]);
        st8bf(SGA + (size_t)(m0 + lrow) * 1024 + n0 - 3072 + lc0, v);
      EPI8_END
    }
  }
}

DI void ph_qkv(const Params& P, char* smem) {
  const bf16_t* CQ = (const bf16_t*)(P.ws + OFF_CQ);
  const bf16_t* CKV = (const bf16_t*)(P.ws + OFF_CKV);
  const bf16_t* KR = (const bf16_t*)(P.ws + OFF_KR);
  const bf16_t* U = (const bf16_t*)(P.ws + OFF_U);
  const float2* ROPE = (const float2*)(P.ws + OFF_ROPE);
  bf16_t* Q = (bf16_t*)((char*)P.out + OFF_Q);
  bf16_t* KM = (bf16_t*)((char*)P.out + OFF_K);
  bf16_t* VT = (bf16_t*)((char*)P.out + OFF_VT);
  float* S = (float*)(P.ws + OFF_S);
  const float* rss = (const float*)(smem + OFF_RSS);
  float* st = (float*)smem;
  const int NU = 3072 + 4096 + 1024;
  for (int u = blockIdx.x; u < NU; u += gridDim.x) {
    f32x16 acc[2][2];
    if (u < 3072) {
      const int nt = u % 6, mt = u / 6, m0 = mt * 128, n0 = nt * 128;
      gemm_main1<ARow, true>(acc, ARow{CQ, 256}, m0, (const bf16_t*)(P.ws + OFF_WUQ), 256, n0, 256, smem);
      stage_acc(acc, st);
      EPI8_BEGIN(st, 8, 4)
        const int col = n0 + lc0, head = col / 96, c = col - head * 96, tok = m0 + lrow;
        const float sc = rsqrtf(rss[lrow] * (1.f / 256.f) + 1e-6f) * QSCALE;
        float o[8];
        if (c >= 64) {
          const float2* cs = ROPE + tok_pos(tok) * 16 + (c & 15);
          float pv[8]; ld8(st + lrow * STL + (lc0 ^ 16), pv);
#pragma unroll
          for (int j = 0; j < 8; ++j) o[j] = ((c & 16) ? pv[j] * cs[j].y + v[j] * cs[j].x : v[j] * cs[j].x - pv[j] * cs[j].y) * sc;
        } else {
#pragma unroll
          for (int j = 0; j < 8; ++j) o[j] = v[j] * sc;
        }
        st8bf(Q + ((size_t)head * MT + tok) * 96 + c, o);
      EPI8_END
    } else if (u < 3072 + 4096) {
      const int v2 = u - 3072, head = v2 & 7, mt = v2 >> 3, m0 = mt * 128, n0 = head * 128;
      gemm_main1<ARow, true>(acc, ARow{CKV, 128}, m0, (const bf16_t*)(P.ws + OFF_WUKV), 128, n0, 128, smem);
      stage_acc(acc, st);
#pragma unroll 1
      for (int it = 0; it < 4; ++it) {
        const int gid = it * 256 + threadIdx.x, lrow = gid >> 3, lc0 = (gid & 7) * 8, tok = m0 + lrow;
        const float sc = rsqrtf(rss[lrow] * (1.f / 128.f) + 1e-6f);
        float v[8]; ld8(st + lrow * STL + lc0, v);
#pragma unroll
        for (int j = 0; j < 8; ++j) v[j] *= sc;
        st8bf(KM + ((size_t)head * MT + tok) * 96 + lc0, v);
      }
#pragma unroll 1
      for (int it = 0; it < 4; ++it) {
        const int gid = it * 256 + threadIdx.x, dv = gid >> 4, rg = (gid & 15) * 8;
        float v[8];
#pragma unroll
        for (int j = 0; j < 8; ++j) v[j] = st[(rg + j) * STL + 64 + dv] * rsqrtf(rss[rg + j] * (1.f / 128.f) + 1e-6f);
        st8bf(VT + ((size_t)head * 64 + dv) * MT + m0 + rg, v);
      }
      {
        const int tok = m0 + (threadIdx.x >> 1), hf = threadIdx.x & 1;
        const u32x4* sp = (const u32x4*)(KR + (size_t)tok * 32 + hf * 16);
        u32x4* d = (u32x4*)(KM + ((size_t)head * MT + tok) * 96 + 64 + hf * 16);
        d[0] = sp[0]; d[1] = sp[1];
      }
      __syncthreads();
    } else {
      const int v2 = u - 7168, nt = v2 & 1, mt = (v2 >> 1) & 15, g = v2 >> 5, m0 = mt * 128, n0 = nt * 128;
      gemm_main1<ARow, false>(acc, ARow{U + (size_t)g * MT * 16, 512}, m0, (const bf16_t*)(P.ws + OFF_WST) + (size_t)g * 256 * 512, 512, n0, 512, smem);
      stage_acc(acc, st);
      EPI8_BEGIN(st, 8, 4)
        float* d = S + ((size_t)g * NCH + m0 + lrow) * 256 + n0 + lc0;
        *(float4*)d = make_float4(v[0], v[1], v[2], v[3]); *(float4*)(d + 4) = make_float4(v[4], v[5], v[6], v[7]);
      EPI8_END
    }
  }
}

DI void ph_scan(const Params& P, char* smem) {
  const float* S = (const float*)(P.ws + OFF_S);
  bf16_t* HST = (bf16_t*)(P.ws + OFF_HST);
  const float2* LP = (const float2*)(P.ws + OFF_LP);
  float2* E = (float2*)smem;
  const int n = threadIdx.x & 63, sg = threadIdx.x >> 6;
  for (int job = blockIdx.x; job < 384; job += gridDim.x) {
    const int dir = job & 1, g = (job >> 1) & 31, seq = job >> 6;
    const int c0 = seq < 2 ? seq * 512 : 1024 + (seq - 2) * 256, nc = seq < 2 ? 512 : 256, segl = nc >> 2;
    const float2 a = LP[((g * 2 + dir) * 33 + 32) * 64 + n];
    const float* Sg = S + (size_t)g * NCH * 256 + dir * 128 + n;
    bf16_t* Hg = HST + (size_t)g * NCH * 256 + dir * 128 + n;
    const int j0 = sg * segl;
    float hr = 0.f, hi = 0.f;
    for (int jb = 0; jb < segl; jb += 32) {
      float sr[32], si[32];
#pragma unroll
      for (int j = 0; j < 32; ++j) { const int jj = j0 + jb + j, c = dir ? (c0 + nc - 1 - jj) : (c0 + jj); sr[j] = Sg[(size_t)c * 256]; si[j] = Sg[(size_t)c * 256 + 64]; }
#pragma unroll
      for (int j = 0; j < 32; ++j) { const float nr = a.x * hr - a.y * hi + sr[j], ni = a.x * hi + a.y * hr + si[j]; hr = nr; hi = ni; }
    }
    E[sg * 64 + n] = make_float2(hr, hi);
    float pr = a.x, pi = a.y;
    for (int q = segl; q > 1; q >>= 1) { const float nr = pr * pr - pi * pi, ni = 2.f * pr * pi; pr = nr; pi = ni; }
    __syncthreads();
    hr = 0.f; hi = 0.f;
    for (int t = 0; t < sg; ++t) { const float2 e = E[t * 64 + n]; const float nr = pr * hr - pi * hi + e.x, ni = pr * hi + pi * hr + e.y; hr = nr; hi = ni; }
    for (int jb = 0; jb < segl; jb += 32) {
      float sr[32], si[32];
#pragma unroll
      for (int j = 0; j < 32; ++j) { const int jj = j0 + jb + j, c = dir ? (c0 + nc - 1 - jj) : (c0 + jj); sr[j] = Sg[(size_t)c * 256]; si[j] = Sg[(size_t)c * 256 + 64]; }
#pragma unroll
      for (int j = 0; j < 32; ++j) {
        const int jj = j0 + jb + j, c = dir ? (c0 + nc - 1 - jj) : (c0 + jj);
        Hg[(size_t)c * 256] = f2bf(hr); Hg[(size_t)c * 256 + 64] = f2bf(hi);
        const float nr = a.x * hr - a.y * hi + sr[j], ni = a.x * hi + a.y * hr + si[j]; hr = nr; hi = ni;
      }
    }
    __syncthreads();
  }
}

DI void attn_unit(const Params& P, int tok0, int L, int head, int q0, char* smem) {
  const int tid = threadIdx.x, lane = tid & 63, wave = tid >> 6, r = lane & 31, h = lane >> 5;
  const bf16_t* Qh = (const bf16_t*)((char*)P.out + OFF_Q) + (size_t)head * MT * 96;
  const bf16_t* Kh = (const bf16_t*)((char*)P.out + OFF_K) + ((size_t)head * MT + tok0) * 96;
  const bf16_t* Vh = (const bf16_t*)((char*)P.out + OFF_VT) + (size_t)head * 64 * MT + tok0;
  const bf16_t* SZA = (const bf16_t*)(P.ws + OFF_SZA);
  bf16_t* YA = (bf16_t*)(P.ws + OFF_YA);
  const int qtok = tok0 + q0 + wave * 32 + r;
  bf16x8 qf[6];
#pragma unroll
  for (int ks = 0; ks < 6; ++ks) qf[ks] = *(const bf16x8*)(Qh + (size_t)qtok * 96 + ks * 16 + h * 8);
  f32x16 O[2];
  f32x16 negm;
#pragma unroll
  for (int i = 0; i < 16; ++i) { O[0][i] = 0.f; O[1][i] = 0.f; negm[i] = 0.f; }
  float l = 0.f;
  u32x4 rk[3], rv[2];
  int kgo[3], klo[3];
#pragma unroll
  for (int i = 0; i < 3; ++i) { const int id = tid + 256 * i, kr = id / 12, kc = id - kr * 12; kgo[i] = kr * 96 + kc * 8; klo[i] = kr * 208 + kc * 16; }
  const int vrow = tid >> 3, vch = tid & 7;
  const int nkt = L >> 6;
#pragma unroll
  for (int i = 0; i < 3; ++i) rk[i] = *(const u32x4*)(Kh + kgo[i]);
#pragma unroll
  for (int i = 0; i < 2; ++i) rv[i] = *(const u32x4*)(Vh + (size_t)(vrow + 32 * i) * MT + vch * 8);
  for (int kt = 0; kt < nkt; ++kt) {
    char* sk = smem + (kt & 1) * 22016;
    char* sv = sk + 13312;
#pragma unroll
    for (int i = 0; i < 3; ++i) *(u32x4*)(sk + klo[i]) = rk[i];
#pragma unroll
    for (int i = 0; i < 2; ++i) {
      char* d = sv + (vrow + 32 * i) * 136 + vch * 16;
      *(u32x2*)d = (u32x2){rv[i].x, rv[i].y};
      *(u32x2*)(d + 8) = (u32x2){rv[i].z, rv[i].w};
    }
    __syncthreads();
    if (kt + 1 < nkt) {
      const int key0 = (kt + 1) * 64;
#pragma unroll
      for (int i = 0; i < 3; ++i) rk[i] = *(const u32x4*)(Kh + (size_t)key0 * 96 + kgo[i]);
#pragma unroll
      for (int i = 0; i < 2; ++i) rv[i] = *(const u32x4*)(Vh + (size_t)(vrow + 32 * i) * MT + key0 + vch * 8);
    }
    f32x16 S[2];
#pragma unroll
    for (int kb = 0; kb < 2; ++kb) {
#pragma unroll
      for (int ks = 0; ks < 6; ++ks) {
        const bf16x8 kf = *(const bf16x8*)(sk + (kb * 32 + r) * 208 + (ks * 2 + h) * 16);
        S[kb] = __builtin_amdgcn_mfma_f32_32x32x16_bf16(kf, qf[ks], ks == 0 ? negm : S[kb], 0, 0, 0);
      }
    }
    float mx = fmaxf(fmaxf(S[0][0], S[0][1]), S[0][2]);
#pragma unroll
    for (int i = 3; i < 15; i += 2) mx = fmaxf(fmaxf(mx, S[0][i]), S[0][i + 1]);
    mx = fmaxf(mx, S[0][15]);
#pragma unroll
    for (int i = 0; i < 16; i += 2) mx = fmaxf(fmaxf(mx, S[1][i]), S[1][i + 1]);
    if (kt == 0 || __any(mx > 8.f)) {
      const float mxf = fmaxf(mx, __shfl_xor(mx, 32));
      const float delta = kt == 0 ? mxf : fmaxf(mxf, 0.f);
      const float alpha = kt == 0 ? 1.f : __builtin_amdgcn_exp2f(-delta);
      l *= alpha;
      const float nm = negm[0] - delta;
#pragma unroll
      for (int i = 0; i < 16; ++i) { O[0][i] *= alpha; O[1][i] *= alpha; S[0][i] -= delta; S[1][i] -= delta; negm[i] = nm; }
    }
    float ps = 0.f;
#pragma unroll
    for (int kb = 0; kb < 2; ++kb)
#pragma unroll
      for (int i = 0; i < 16; ++i) { S[kb][i] = __builtin_amdgcn_exp2f(S[kb][i]); ps += S[kb][i]; }
    l += ps;
    bf16x8 pf[2][2];
#pragma unroll
    for (int kb = 0; kb < 2; ++kb)
#pragma unroll
      for (int s = 0; s < 2; ++s) {
        u32x4 w;
        w.x = pk2(S[kb][8 * s + 0], S[kb][8 * s + 1]); w.y = pk2(S[kb][8 * s + 2], S[kb][8 * s + 3]);
        w.z = pk2(S[kb][8 * s + 4], S[kb][8 * s + 5]); w.w = pk2(S[kb][8 * s + 6], S[kb][8 * s + 7]);
        pf[kb][s] = __builtin_bit_cast(bf16x8, w);
      }
#pragma unroll
    for (int db = 0; db < 2; ++db)
#pragma unroll
      for (int kb = 0; kb < 2; ++kb)
#pragma unroll
        for (int s = 0; s < 2; ++s) {
          const char* a = sv + (db * 32 + r) * 136 + (kb * 32 + s * 16 + h * 4) * 2;
          const u32x2 lo = *(const u32x2*)a, hi = *(const u32x2*)(a + 16);
          const u32x4 w = {lo.x, lo.y, hi.x, hi.y};
          O[db] = __builtin_amdgcn_mfma_f32_32x32x16_bf16(__builtin_bit_cast(bf16x8, w), pf[kb][s], O[db], 0, 0, 0);
        }
  }
  __syncthreads();
  l += __shfl_xor(l, 32);
  const float inv = 1.f / l;
#pragma unroll
  for (int db = 0; db < 2; ++db)
#pragma unroll
    for (int g4 = 0; g4 < 4; ++g4) {
      const size_t o = (size_t)qtok * 512 + head * 64 + db * 32 + 8 * g4 + 4 * h;
      const u32x2 gz = *(const u32x2*)(SZA + o);
      const float g0 = __uint_as_float(gz.x << 16), g1 = __uint_as_float(gz.x & 0xffff0000u), g2 = __uint_as_float(gz.y << 16), g3 = __uint_as_float(gz.y & 0xffff0000u);
      u32x2 w;
      w.x = pk2(O[db][4 * g4 + 0] * inv * g0, O[db][4 * g4 + 1] * inv * g1);
      w.y = pk2(O[db][4 * g4 + 2] * inv * g2, O[db][4 * g4 + 3] * inv * g3);
#ifdef PROBE_NO_ATTN
      w.x = 0; w.y = 0;
#endif
      *(u32x2*)(YA + o) = w;
    }
}

DI void ph_mix(const Params& P, char* smem) {
  const bf16_t* U = (const bf16_t*)(P.ws + OFF_U);
  const bf16_t* HST = (const bf16_t*)(P.ws + OFF_HST);
  bf16_t* Y = (bf16_t*)(P.ws + OFF_S);
  const int NU = 2048 + 4096;
  for (int u = blockIdx.x; u < NU; u += gridDim.x) {
    if (u < 2048) {
      const int nt = u & 3, mt = (u >> 2) & 15, g = u >> 6, m0 = mt * 128, n0 = nt * 128;
      f32x16 acc[2][2];
      gemm_main1<ATwo, false>(acc, ATwo{U + (size_t)g * MT * 16, 512, 64, HST + (size_t)g * NCH * 256, 256}, m0,
                             (const bf16_t*)(P.ws + OFF_WOUT) + (size_t)g * 512 * 768, 768, n0, 768, smem);
      float* st = (float*)smem;
      stage_acc(acc, st);
      EPI8_BEGIN(st, 8, 4)
#pragma unroll
        for (int j = 0; j < 8; ++j) v[j] = geluf_(v[j]);
        st8bf(Y + ((size_t)g * NCH + m0 + lrow) * 512 + n0 + lc0, v);
      EPI8_END
    } else {
      const int v2 = u - 2048;
      const int head = v2 & 7, w = v2 >> 3;
      int tok0, L, qb;
      if (w < 256) { const int seq = w >> 7; qb = w & 127; tok0 = seq * 16384; L = 16384; }
      else { const int w2 = w - 256; const int seq = w2 >> 6; qb = w2 & 63; tok0 = 32768 + seq * 8192; L = 8192; }
#ifdef PROBE_ATTN_TWICE
#pragma unroll 1
      for (int rep_ = 0; rep_ < 2; ++rep_)
#endif
      attn_unit(P, tok0, L, head, qb * 128, smem);
    }
  }
}

DI void ph_glu(const Params& P, char* smem) {
  const bf16_t* Y = (const bf16_t*)(P.ws + OFF_S);
  const bf16_t* SZS = (const bf16_t*)(P.ws + OFF_SZS);
  bf16_t* YS = (bf16_t*)(P.ws + OFF_U);
  for (int u = blockIdx.x; u < 2048; u += gridDim.x) {
    const int nt = u & 3, mt = u >> 2, m0 = mt * 128, n0 = nt * 128;
    f32x16 acc[2][2];
    gemm_main<AGrp, false>(acc, AGrp{Y}, m0, (const bf16_t*)(P.ws + OFF_WGLU), 512, n0, 512, smem);
    float* st = (float*)smem;
    stage_acc(acc, st);
    EPI8_BEGIN(st, 8, 4)
      const int col = n0 + lc0, tok = m0 + lrow;
      float y[8], z[8], o[8];
      ld8bf(Y + ((size_t)(col >> 4) * MT + tok) * 16 + (col & 15), y);
      ld8bf(SZS + (size_t)tok * 512 + col, z);
#pragma unroll
      for (int j = 0; j < 8; ++j) o[j] = y[j] * sigmoidf_(v[j] + P.b_glu[col + j]) * z[j];
      st8bf(YS + (size_t)tok * 512 + col, o);
    EPI8_END
  }
}

DI void ph_merge(const Params& P, char* smem) {
  const bf16_t* YS = (const bf16_t*)(P.ws + OFF_U);
  const bf16_t* YA = (const bf16_t*)(P.ws + OFF_YA);
  const bf16_t* SGS = (const bf16_t*)(P.ws + OFF_SGS);
  const bf16_t* SGA = (const bf16_t*)(P.ws + OFF_SGA);
  bf16_t* MG = (bf16_t*)(P.ws + OFF_X0);
  for (int u = blockIdx.x; u < 4096; u += gridDim.x) {
    const int nt = u & 7, mt = u >> 3, m0 = mt * 128, n0 = nt * 128;
    f32x16 acc[2][2];
    float* st = (float*)smem;
#pragma unroll 1
    for (int pass = 0; pass < 2; ++pass) {
      const bf16_t* A = pass ? YA : YS;
      const bf16_t* B = (const bf16_t*)(P.ws + (pass ? OFF_WBA : OFF_WBS));
      const bf16_t* G = pass ? SGA : SGS;
      gemm_main<ARow, false>(acc, ARow{A, 512}, m0, B, 512, n0, 512, smem);
      stage_acc(acc, st);
      EPI8_BEGIN(st, 8, 4)
        const size_t o = (size_t)(m0 + lrow) * 1024 + n0 + lc0;
        float gte[8]; ld8bf(G + o, gte);
#pragma unroll
        for (int j = 0; j < 8; ++j) v[j] *= gte[j];
        if (pass) {
          float pr[8]; ld8bf(MG + o, pr);
#pragma unroll
          for (int j = 0; j < 8; ++j) v[j] += pr[j];
        }
        st8bf(MG + o, v);
      EPI8_END
    }
  }
}

DI void ph_out(const Params& P, char* smem) {
  const bf16_t* MG = (const bf16_t*)(P.ws + OFF_X0);
  const float2* STATS = (const float2*)(P.ws + OFF_STATS);
  for (int u = blockIdx.x; u < 4096; u += gridDim.x) {
    const int nt = u & 7, mt = u >> 3, m0 = mt * 128, n0 = nt * 128;
    f32x16 acc[2][2];
    gemm_main<ARow, false>(acc, ARow{MG, 1024}, m0, (const bf16_t*)(P.ws + OFF_WO), 1024, n0, 1024, smem);
    float* st = (float*)smem;
    stage_acc(acc, st);
    EPI8_BEGIN(st, 8, 4)
      const int tok = m0 + lrow, col = n0 + lc0;
      const float* xp = tok < 32768 ? P.x_prompt + (size_t)tok * DM + col : P.x_sample + (size_t)(tok - 32768) * DM + col;
      float xv[8], gg[8], bb[8];
      ld8(xp, xv); ld8(P.ln_in_g + col, gg); ld8(P.ln_in_b + col, bb);
      const float2 stt = STATS[tok];
#pragma unroll
      for (int j = 0; j < 8; ++j) v[j] += ALPHA_RES * ((xv[j] - stt.x) * stt.y * gg[j] + bb[j]);
      float* d = P.out + (size_t)tok * DM + col;
      *(float4*)d = make_float4(v[0], v[1], v[2], v[3]); *(float4*)(d + 4) = make_float4(v[4], v[5], v[6], v[7]);
    EPI8_END
  }
}

DI void ph_final_ln(const Params& P) {
  const int gt = blockIdx.x * blockDim.x + threadIdx.x, gs = gridDim.x * blockDim.x;
  const int lane = threadIdx.x & 63, gw = gt >> 6, nw = gs >> 6;
  for (int row0 = gw * 4; row0 < MT; row0 += nw * 4) {
    float4 v[4][4];
#pragma unroll
    for (int rr = 0; rr < 4; ++rr)
#pragma unroll
      for (int i = 0; i < 4; ++i) v[rr][i] = *(const float4*)(P.out + (size_t)(row0 + rr) * DM + i * 256 + lane * 4);
#pragma unroll
    for (int rr = 0; rr < 4; ++rr) {
      float* zr = P.out + (size_t)(row0 + rr) * DM;
      float s = 0.f;
#pragma unroll
      for (int i = 0; i < 4; ++i) s += (v[rr][i].x + v[rr][i].y) + (v[rr][i].z + v[rr][i].w);
#pragma unroll
      for (int o = 32; o >= 1; o >>= 1) s += __shfl_xor(s, o);
      const float mu = s * (1.f / 1024.f);
      float q = 0.f;
#pragma unroll
      for (int i = 0; i < 4; ++i) { const float a = v[rr][i].x - mu, b = v[rr][i].y - mu, c = v[rr][i].z - mu, d = v[rr][i].w - mu; q += (a * a + b * b) + (c * c + d * d); }
#pragma unroll
      for (int o = 32; o >= 1; o >>= 1) q += __shfl_xor(q, o);
      const float rstd = rsqrtf(q * (1.f / 1024.f) + 1e-5f);
#pragma unroll
      for (int i = 0; i < 4; ++i) {
        const int c = i * 256 + lane * 4;
        const float4 g = *(const float4*)(P.ln_g + c), b = *(const float4*)(P.ln_b + c);
        float4 o;
        o.x = (v[rr][i].x - mu) * rstd * g.x + b.x; o.y = (v[rr][i].y - mu) * rstd * g.y + b.y;
        o.z = (v[rr][i].z - mu) * rstd * g.z + b.z; o.w = (v[rr][i].w - mu) * rstd * g.w + b.w;
        *(float4*)(zr + c) = o;
      }
    }
  }
}

#ifndef N_LAUNCH_MODE
#define N_LAUNCH_MODE 1
#endif

template <int PH> DI void run_phase(const Params& P, char* smem) {
  if (PH == 0) ph_tables(P);
  else if (PH == 1) ph_prep(P, smem);
  else if (PH == 2) ph_g1(P, smem);
  else if (PH == 3) ph_qkv(P, smem);
  else if (PH == 4) ph_scan(P, smem);
  else if (PH == 5) ph_mix(P, smem);
  else if (PH == 6) ph_glu(P, smem);
  else if (PH == 7) ph_merge(P, smem);
  else if (PH == 8) ph_out(P, smem);
  else ph_final_ln(P);
}

#if N_LAUNCH_MODE == 1
__global__ void __launch_bounds__(256, 2) fwd_kernel(Params P_arg) {
  __shared__ __attribute__((aligned(16))) char smem[OFF_RSS + 512];
  cg::grid_group grid = cg::this_grid();
  const Params& P = *(const Params*)__builtin_amdgcn_kernarg_segment_ptr();
#if defined(REP_PHASE) && REP_PHASE == 0
  _Pragma("unroll 1") for (int rep_ = 0; rep_ < 2; ++rep_)
#endif
  run_phase<0>(P, smem); grid.sync();
#if defined(REP_PHASE) && REP_PHASE == 1
  _Pragma("unroll 1") for (int rep_ = 0; rep_ < 2; ++rep_)
#endif
  run_phase<1>(P, smem); grid.sync();
#if defined(REP_PHASE) && REP_PHASE == 2
  _Pragma("unroll 1") for (int rep_ = 0; rep_ < 2; ++rep_)
#endif
  run_phase<2>(P, smem); grid.sync();
#if defined(REP_PHASE) && REP_PHASE == 3
  _Pragma("unroll 1") for (int rep_ = 0; rep_ < 2; ++rep_)
#endif
  run_phase<3>(P, smem); grid.sync();
#if defined(REP_PHASE) && REP_PHASE == 4
  _Pragma("unroll 1") for (int rep_ = 0; rep_ < 2; ++rep_)
#endif
  run_phase<4>(P, smem); grid.sync();
#if defined(REP_PHASE) && REP_PHASE == 5
  _Pragma("unroll 1") for (int rep_ = 0; rep_ < 2; ++rep_)
#endif
  run_phase<5>(P, smem); grid.sync();
#if defined(REP_PHASE) && REP_PHASE == 6
  _Pragma("unroll 1") for (int rep_ = 0; rep_ < 2; ++rep_)
#endif
  run_phase<6>(P, smem); grid.sync();
#if defined(REP_PHASE) && REP_PHASE == 7
  _Pragma("unroll 1") for (int rep_ = 0; rep_ < 2; ++rep_)
#endif
  run_phase<7>(P, smem); grid.sync();
#if defined(REP_PHASE) && REP_PHASE == 8
  _Pragma("unroll 1") for (int rep_ = 0; rep_ < 2; ++rep_)
#endif
  run_phase<8>(P, smem); grid.sync();
#if defined(REP_PHASE) && REP_PHASE == 9
  _Pragma("unroll 1") for (int rep_ = 0; rep_ < 2; ++rep_)
#endif
  run_phase<9>(P, smem);
}
#else
template <int PH> __global__ void __launch_bounds__(256, 2) phase_kernel(Params P) {
  __shared__ __attribute__((aligned(16))) char smem[OFF_RSS + 512];
  run_phase<PH>(P, smem);
}
#endif

extern "C" void kernel_launch(void* const* d_in, const int* in_sizes, int n_in, void* d_out, int out_size, void* d_ws, size_t ws_size, hipStream_t stream) {
  if (ws_size < WS_NEEDED) { fprintf(stderr, "workspace too small: %zu < %zu\n", ws_size, WS_NEEDED); return; }
  Params p{};
  const float** f = (const float**)&p;
  for (int i = 0; i < 29; ++i) f[i] = (const float*)d_in[i];
  p.out = (float*)d_out;
  p.ws = (char*)d_ws;
  static int grid_blocks = 0;
#if N_LAUNCH_MODE == 1
  if (!grid_blocks) {
    int dev = 0, cus = 0, per_cu = 0;
    (void)hipGetDevice(&dev);
    (void)hipDeviceGetAttribute(&cus, hipDeviceAttributeMultiprocessorCount, dev);
    (void)hipOccupancyMaxActiveBlocksPerMultiprocessor(&per_cu, fwd_kernel, 256, 0);
    if (per_cu > 2) per_cu = 2;
    if (per_cu < 1) per_cu = 1;
    grid_blocks = cus * per_cu;
  }
  void* args[] = {&p};
  hipError_t e = hipLaunchCooperativeKernel((void*)fwd_kernel, dim3(grid_blocks), dim3(256), args, 0, stream);
  if (e != hipSuccess) fprintf(stderr, "cooperative launch failed: %s (grid %d)\n", hipGetErrorString(e), grid_blocks);
#else
  grid_blocks = 512;
  hipLaunchKernelGGL(phase_kernel<0>, dim3(grid_blocks), dim3(256), 0, stream, p);
  hipLaunchKernelGGL(phase_kernel<1>, dim3(grid_blocks), dim3(256), 0, stream, p);
  hipLaunchKernelGGL(phase_kernel<2>, dim3(grid_blocks), dim3(256), 0, stream, p);
  hipLaunchKernelGGL(phase_kernel<3>, dim3(grid_blocks), dim3(256), 0, stream, p);
  hipLaunchKernelGGL(phase_kernel<4>, dim3(grid_blocks), dim3(256), 0, stream, p);
  hipLaunchKernelGGL(phase_kernel<5>, dim3(grid_blocks), dim3(256), 0, stream, p);
  hipLaunchKernelGGL(phase_kernel<6>, dim3(grid_blocks), dim3(256), 0, stream, p);
  hipLaunchKernelGGL(phase_kernel<7>, dim3(grid_blocks), dim3(256), 0, stream, p);
  hipLaunchKernelGGL(phase_kernel<8>, dim3(grid_blocks), dim3(256), 0, stream, p);
  hipLaunchKernelGGL(phase_kernel<9>, dim3(grid_blocks), dim3(256), 0, stream, p);
#endif
}
```

```cpp
#include <hip/hip_runtime.h>
#include <hip/hip_cooperative_groups.h>
#include <cstdint>
#include <cstdio>
namespace cg = cooperative_groups;

#define DI __device__ __forceinline__
typedef unsigned short bf16_t;
typedef short bf16x8 __attribute__((ext_vector_type(8)));
typedef float f32x16 __attribute__((ext_vector_type(16)));
typedef float f32x4v __attribute__((ext_vector_type(4)));
typedef unsigned u32x4 __attribute__((ext_vector_type(4)));
typedef unsigned u32x2 __attribute__((ext_vector_type(2)));

constexpr int MT = 65536;
constexpr int DM = 1024;
constexpr int TCH = 32;
constexpr int NCH = MT / TCH;
constexpr size_t MiB = (size_t)1 << 20;

constexpr int LDX = 1088;
constexpr int LD5 = 576;
constexpr int LDQ = 320;
constexpr int LDKV = 192;
constexpr int LDWO = 832;
constexpr int LDV = MT + 128;
constexpr size_t OFF_X0 = 0;
constexpr size_t OFF_S = 0;
constexpr size_t OFF_HST = 64 * MiB;
constexpr size_t OFF_U = 136 * MiB;
constexpr size_t OFF_SZS = 208 * MiB;
constexpr size_t OFF_SZA = 272 * MiB;
constexpr size_t OFF_SGS = 336 * MiB;
constexpr size_t OFF_SGA = 464 * MiB;
constexpr size_t OFF_CQ = 592 * MiB;
constexpr size_t OFF_CKV = 632 * MiB;
constexpr size_t OFF_KR = 656 * MiB;
constexpr size_t OFF_YA = 660 * MiB;
constexpr size_t OFF_VT = 732 * MiB;
constexpr size_t OFF_W1T = 797 * MiB;
constexpr size_t OFF_WUQ = 806 * MiB;
constexpr size_t OFF_WUKV = OFF_WUQ + MiB / 2;
constexpr size_t OFF_WGLU = OFF_WUKV + MiB / 2;
constexpr size_t OFF_WBS = OFF_WGLU + MiB;
constexpr size_t OFF_WBA = OFF_WBS + 3 * MiB / 2;
constexpr size_t OFF_WO = OFF_WBA + 3 * MiB / 2;
constexpr size_t OFF_WST = OFF_WO + 5 * MiB / 2;
constexpr size_t OFF_WOUT = OFF_WST + 9 * MiB;
constexpr size_t OFF_LP = OFF_WOUT + 26 * MiB;
constexpr size_t OFF_BT = OFF_LP + 2 * MiB;
constexpr size_t OFF_KT = OFF_BT + MiB;
constexpr size_t OFF_ROPE = OFF_KT + 2 * MiB;
constexpr size_t OFF_STATS = OFF_ROPE + 2 * MiB;
constexpr size_t OFF_BAR = OFF_STATS + 768 * 1024;
constexpr size_t WS_NEEDED = OFF_STATS + MiB;
constexpr size_t OFF_Q = 0;
constexpr size_t OFF_K = 96 * MiB;

constexpr float ALPHA_RES = 1.18920711500272f;
constexpr float QSCALE = 0.14724444f;

struct Params {
  const float *x_prompt, *x_sample, *ln_in_g, *ln_in_b, *w_in, *b_re, *b_im, *a_re_f, *a_im_f, *ldt_f, *c_re_f, *c_im_f, *a_re_b, *a_im_b,
      *ldt_b, *c_re_b, *c_im_b, *ssm_d, *w_glu, *b_glu, *q_norm_g, *w_uq, *kv_norm_g, *w_ukv, *w_bs, *w_ba, *w_o, *ln_g, *ln_b;
  float* out;
  char* ws;
  int pad0, pad1;
};

DI int tidx() { int t = threadIdx.x; asm volatile("" : "+v"(t)); return t; }
DI bf16_t f2bf(float x) { unsigned u = __float_as_uint(x); u += 0x7fffu + ((u >> 16) & 1u); return (bf16_t)(u >> 16); }
DI unsigned pk2(float lo, float hi) { unsigned r; asm("v_cvt_pk_bf16_f32 %0, %1, %2" : "=v"(r) : "v"(lo), "v"(hi)); return r; }
DI float bf2f(bf16_t b) { return __uint_as_float(((unsigned)b) << 16); }
DI float sigmoidf_(float x) { return __builtin_amdgcn_rcpf(1.f + __expf(-x)); }
DI float siluf_(float x) { return x * sigmoidf_(x); }
DI float geluf_(float x) { return x * sigmoidf_(1.5957691216057308f * (x + 0.044715f * x * x * x)); }
DI int crow(int i, int h) { return (i & 3) + 8 * (i >> 2) + 4 * h; }
DI int tok_pos(int t) { return t < 32768 ? (t & 16383) : (t & 8191); }

DI void sincos2pi(double rev, double& s, double& c) {
  rev -= rint(rev);
  double q = rint(rev * 4.0);
  double y = (rev - q * 0.25) * 6.283185307179586476925;
  double y2 = y * y;
  double sp = y * (1.0 + y2 * (-1.0 / 6 + y2 * (1.0 / 120 + y2 * (-1.0 / 5040 + y2 * (1.0 / 362880 + y2 * (-1.0 / 39916800 + y2 * (1.0 / 6227020800.0)))))));
  double cp = 1.0 + y2 * (-0.5 + y2 * (1.0 / 24 + y2 * (-1.0 / 720 + y2 * (1.0 / 40320 + y2 * (-1.0 / 3628800 + y2 * (1.0 / 479001600.0 + y2 * (-1.0 / 87178291200.0)))))));
  int qi = ((int)q) & 3;
  if (qi == 0) { s = sp; c = cp; } else if (qi == 1) { s = cp; c = -sp; } else if (qi == 2) { s = -sp; c = -cp; } else { s = -cp; c = sp; }
}

struct ARow { const bf16_t* p; int ld; DI const bf16_t* operator()(int row, int kc) const { return p + (size_t)row * ld + kc * 8; } };
struct ATwo { const bf16_t* p1; int ld1; int kc1; const bf16_t* p2; int ld2;
  DI const bf16_t* operator()(int row, int kc) const { return kc < kc1 ? p1 + (size_t)row * ld1 + kc * 8 : p2 + (size_t)row * ld2 + (kc - kc1) * 8; } };
struct AGrp { const bf16_t* p; DI const bf16_t* operator()(int row, int kc) const { return p + ((size_t)(kc >> 1) * MT + row) * 16 + (kc & 1) * 8; } };

constexpr int NTHR = 512;
constexpr int STL = 260;
constexpr int OFF_RSS = 256 * 264 * 2;
constexpr int OFF_XBW = OFF_RSS + 1024;
constexpr int SMEM_BYTES = OFF_XBW + 16;
DI int swz(int row, int c) { return row * 128 + ((c ^ ((row >> 1) & 7)) << 4); }

template <class AL, bool ROWSS>
DI void gemm_main(f32x4v (&acc)[8][4], const AL& al, int m0, const bf16_t* __restrict__ Bt, int ldb, int n0, int K, char* smem) {
  const int tid = tidx(), lane = tid & 63, wave = tid >> 6, wm = wave >> 2, wn = wave & 3, fr = lane & 15, fq = lane >> 4;
  const int nk = K >> 6;
#pragma unroll
  for (int m = 0; m < 8; ++m)
#pragma unroll
    for (int n = 0; n < 4; ++n) acc[m][n] = (f32x4v){0.f, 0.f, 0.f, 0.f};
  const int prow = wave * 8 + (lane >> 3);
  const int pch = (lane & 7) ^ ((prow >> 1) & 7);
  const bf16_t* bp = Bt + (size_t)(n0 + prow) * ldb + pch * 8;
#define GLDS_A(BUF, KT)                                                                                                      \
  _Pragma("unroll") for (int i = 0; i < 4; ++i)                                                                               \
    __builtin_amdgcn_global_load_lds((const unsigned*)al(m0 + prow + 64 * i, (KT) * 8 + pch),                                \
                                     (unsigned __attribute__((address_space(3)))*)(smem + (BUF) * 65536 + (i * 64 + wave * 8) * 128), 16, 0, 0);
#define GLDS_B(BUF, KT)                                                                                                      \
  _Pragma("unroll") for (int i = 0; i < 4; ++i)                                                                               \
    __builtin_amdgcn_global_load_lds((const unsigned*)(bp + (size_t)64 * i * ldb + (KT) * 64),                               \
                                     (unsigned __attribute__((address_space(3)))*)(smem + (BUF) * 65536 + 32768 + (i * 64 + wave * 8) * 128), 16, 0, 0);
#define GLDS_STAGE(BUF, KT) GLDS_A(BUF, KT) GLDS_B(BUF, KT)
  GLDS_STAGE(0, 0)
  asm volatile("s_waitcnt vmcnt(0)" ::: "memory");
  __syncthreads();
  for (int kt = 0; kt < nk; ++kt) {
    const char* sa = smem + (kt & 1) * 65536;
    const char* sb = sa + 32768;
    if (kt + 1 < nk) { GLDS_A((kt + 1) & 1, kt + 1) }
#pragma unroll
    for (int kk = 0; kk < 2; ++kk) {
      if (kk == 1 && kt + 1 < nk) { GLDS_B((kt + 1) & 1, kt + 1) }
      bf16x8 af[8], bfr[4];
#pragma unroll
      for (int m = 0; m < 8; ++m) af[m] = *(const bf16x8*)(sa + swz(wm * 128 + m * 16 + fr, kk * 4 + fq));
#pragma unroll
      for (int n = 0; n < 4; ++n) bfr[n] = *(const bf16x8*)(sb + swz(wn * 64 + n * 16 + fr, kk * 4 + fq));
      __builtin_amdgcn_s_setprio(1);
#pragma unroll
      for (int m = 0; m < 8; ++m)
#pragma unroll
        for (int n = 0; n < 4; ++n) acc[m][n] = __builtin_amdgcn_mfma_f32_16x16x32_bf16(af[m], bfr[n], acc[m][n], 0, 0, 0);
      __builtin_amdgcn_s_setprio(0);
    }
    asm volatile("s_waitcnt vmcnt(0)" ::: "memory");
    __syncthreads();
  }
#undef GLDS_STAGE
#undef GLDS_A
#undef GLDS_B
}

template <int SL> DI void stage_slab(const f32x4v (&acc)[8][4], float* st) {
  const int lane = tidx() & 63, wave = tidx() >> 6, wm = wave >> 2, wn = wave & 3, fr = lane & 15, fq = lane >> 4;
  if (wm == SL) {
#pragma unroll
    for (int m = 0; m < 8; ++m)
#pragma unroll
      for (int n = 0; n < 4; ++n)
#pragma unroll
        for (int j = 0; j < 4; ++j) st[(m * 16 + fq * 4 + j) * STL + wn * 64 + n * 16 + fr] = acc[m][n][j];
  }
  __syncthreads();
}
DI void ld8(const float* st, float (&v)[8]) { const float4 a = *(const float4*)st, b = *(const float4*)(st + 4); v[0] = a.x; v[1] = a.y; v[2] = a.z; v[3] = a.w; v[4] = b.x; v[5] = b.y; v[6] = b.z; v[7] = b.w; }
DI void ld8bf(const bf16_t* p, float (&v)[8]) {
  const u32x4 w = *(const u32x4*)p;
#pragma unroll
  for (int j = 0; j < 4; ++j) { v[2 * j] = __uint_as_float(w[j] << 16); v[2 * j + 1] = __uint_as_float(w[j] & 0xffff0000u); }
}
DI void st8bf(bf16_t* p, const float (&v)[8]) { u32x4 w; w.x = pk2(v[0], v[1]); w.y = pk2(v[2], v[3]); w.z = pk2(v[4], v[5]); w.w = pk2(v[6], v[7]); *(u32x4*)p = w; }
#define EPI_SLAB(SL, ...)                                                     \
  { stage_slab<SL>(acc, st);                                                   \
    _Pragma("unroll 1") for (int it_ = 0; it_ < 8; ++it_) {                     \
      const int gid_ = it_ * NTHR + tidx(); const int srow_ = gid_ >> 5, lrow = (SL) * 128 + srow_, lc0 = (gid_ & 31) * 8; (void)lrow; \
      float v[8]; ld8(st + srow_ * STL + lc0, v);                              \
      __VA_ARGS__ }                                                            \
    __syncthreads(); }
#define EPI_ALL(...) EPI_SLAB(0, __VA_ARGS__) EPI_SLAB(1, __VA_ARGS__)

DI void ph_tables(const Params& P) {
  const int gt = blockIdx.x * blockDim.x + tidx(), gs = gridDim.x * blockDim.x;
  float2* LP = (float2*)(P.ws + OFF_LP);
  float2* BT = (float2*)(P.ws + OFF_BT);
  float2* ROPE = (float2*)(P.ws + OFF_ROPE);
  for (int idx = gt; idx < 32 * 2 * 64; idx += gs) {
    const int n = idx & 63, dir = (idx >> 6) & 1, g = idx >> 7;
    const double are = dir ? (double)P.a_re_b[g * 64 + n] : (double)P.a_re_f[g * 64 + n];
    const double aim = dir ? (double)P.a_im_b[g * 64 + n] : (double)P.a_im_f[g * 64 + n];
    const double dt = exp(dir ? (double)P.ldt_b[g] : (double)P.ldt_f[g]);
    double l1r = 1.0, l1i = 0.0;
    for (int d = 0; d <= 32; ++d) {
      const double mag = exp(are * dt * d);
      double s, c; sincos2pi(aim * dt * d * 0.15915494309189533577, s, c);
      LP[((g * 2 + dir) * 33 + d) * 64 + n] = make_float2((float)(mag * c), (float)(mag * s));
      if (d == 1) { l1r = mag * c; l1i = mag * s; }
    }
    const double zr = are * dt, zi = aim * dt;
    double cr, ci;
    if (zr * zr + zi * zi < 0.25) {
      double tr = 1.0, ti = 0.0, sr = 1.0, si = 0.0;
      for (int k = 1; k < 24; ++k) { const double nr = (tr * zr - ti * zi) / (k + 1), ni = (tr * zi + ti * zr) / (k + 1); tr = nr; ti = ni; sr += tr; si += ti; }
      cr = sr * dt; ci = si * dt;
    } else {
      const double nr = l1r - 1.0, ni = l1i, den = are * are + aim * aim;
      cr = (nr * are + ni * aim) / den; ci = (ni * are - nr * aim) / den;
    }
    for (int q = 0; q < 16; ++q) {
      const double br = P.b_re[(g * 64 + n) * 16 + q], bi = P.b_im[(g * 64 + n) * 16 + q];
      BT[((g * 2 + dir) * 64 + n) * 16 + q] = make_float2((float)(br * cr - bi * ci), (float)(br * ci + bi * cr));
    }
  }
  for (int idx = gt; idx < 16384 * 16; idx += gs) {
    const int j = idx & 15, pos = idx >> 4;
    const double inv = exp(-(double)j * (9.210340371976182736 / 16.0));
    double s, c; sincos2pi((double)pos * inv * 0.15915494309189533577, s, c);
    ROPE[idx] = make_float2((float)c, (float)s);
  }
}

DI void transpose_tile(const float* __restrict__ src, int lds_, int ldd, bf16_t* __restrict__ dst, int k0, int n0, int mode, const float* __restrict__ rowscale, float* tile) {
  const int tid = tidx();
  {
    const int nn = tid & 63, n = n0 + nn;
    int sc = n;
    if (mode == 1) sc = n < 1440 ? n : (n < 1536 ? -1 : n - 96);
#pragma unroll 4
    for (int i = 0; i < 8; ++i) {
      const int kk = (tid >> 6) + 8 * i, k = k0 + kk;
      float v = sc >= 0 ? src[(size_t)k * lds_ + sc] : 0.f;
      if (rowscale) v *= rowscale[k];
      tile[kk * 65 + nn] = v;
    }
  }
  __syncthreads();
  {
    const int kk = tid & 63;
#pragma unroll 4
    for (int i = 0; i < 8; ++i) { const int nn = (tid >> 6) + 8 * i; dst[(size_t)(n0 + nn) * ldd + k0 + kk] = f2bf(tile[kk * 65 + nn]); }
  }
  __syncthreads();
}

DI void ph_prep(const Params& P, char* smem) {
  const int gt = blockIdx.x * blockDim.x + tidx(), gs = gridDim.x * blockDim.x;
  const float2* LP = (const float2*)(P.ws + OFF_LP);
  const float2* BT = (const float2*)(P.ws + OFF_BT);
  float* KT = (float*)(P.ws + OFF_KT);
  bf16_t* WST = (bf16_t*)(P.ws + OFF_WST);
  bf16_t* WOUT = (bf16_t*)(P.ws + OFF_WOUT);
  for (int idx = gt; idx < 32 * 2 * 32 * 256; idx += gs) {
    const int q = idx & 15, p = (idx >> 4) & 15, d = (idx >> 8) & 31, dir = (idx >> 13) & 1, g = idx >> 14;
    const float* cre = (dir ? P.c_re_b : P.c_re_f) + (g * 16 + p) * 64;
    const float* cim = (dir ? P.c_im_b : P.c_im_f) + (g * 16 + p) * 64;
    const float2* lp = LP + ((g * 2 + dir) * 33 + d) * 64;
    const float2* bt = BT + ((g * 2 + dir) * 64) * 16 + q;
    float s = 0.f;
    for (int n = 0; n < 64; ++n) {
      const float2 l = lp[n], b = bt[n * 16];
      const float wr = l.x * b.x - l.y * b.y, wi = l.x * b.y + l.y * b.x;
      s += cre[n] * wr - cim[n] * wi;
    }
    KT[idx] = s;
  }
  for (int idx = gt; idx < 32 * 256 * 512; idx += gs) {
    const int k = idx & 511, np = (idx >> 9) & 255, g = idx >> 17;
    const int q = k & 15, s = k >> 4, n = np & 63, reim = (np >> 6) & 1, dir = np >> 7;
    const int e = dir ? s : (TCH - 1 - s);
    const float2 l = LP[((g * 2 + dir) * 33 + e) * 64 + n], b = BT[((g * 2 + dir) * 64 + n) * 16 + q];
    const float val = reim ? (l.x * b.y + l.y * b.x) : (l.x * b.x - l.y * b.y);
    WST[((size_t)g * 256 + np) * LD5 + k] = f2bf(val);
  }
  for (int idx = gt; idx < 32 * 512 * 256; idx += gs) {
    const int k2 = idx & 255, tp = (idx >> 8) & 511, g = idx >> 17;
    const int n = k2 & 63, reim = (k2 >> 6) & 1, dir = k2 >> 7, p = tp & 15, t = tp >> 4;
    const int e = dir ? (TCH - t) : (t + 1);
    const float2 l = LP[((g * 2 + dir) * 33 + e) * 64 + n];
    const float cr = (dir ? P.c_re_b : P.c_re_f)[(g * 16 + p) * 64 + n], ci = (dir ? P.c_im_b : P.c_im_f)[(g * 16 + p) * 64 + n];
    const float val = reim ? -(cr * l.y + ci * l.x) : (cr * l.x - ci * l.y);
#ifdef PROBE_NO_CONV
    WOUT[((size_t)g * 512 + tp) * LDWO + 512 + k2] = 0;
#else
    WOUT[((size_t)g * 512 + tp) * LDWO + 512 + k2] = f2bf(val);
#endif
  }
  {
    float* tile = (float*)smem;
    for (int u = blockIdx.x; u < 1680; u += gridDim.x) {
      if (u < 1024) transpose_tile(P.w_in, 4000, LDX, (bf16_t*)(P.ws + OFF_W1T), (u & 15) * 64, (u >> 4) * 64, 1, nullptr, tile);
      else if (u < 1072) { const int v = u - 1024; transpose_tile(P.w_uq, 768, LDQ, (bf16_t*)(P.ws + OFF_WUQ), (v & 3) * 64, (v >> 2) * 64, 0, P.q_norm_g, tile); }
      else if (u < 1104) { const int v = u - 1072; transpose_tile(P.w_ukv, 1024, LDKV, (bf16_t*)(P.ws + OFF_WUKV), (v & 1) * 64, (v >> 1) * 64, 0, P.kv_norm_g, tile); }
      else if (u < 1168) { const int v = u - 1104; transpose_tile(P.w_glu, 512, LD5, (bf16_t*)(P.ws + OFF_WGLU), (v & 7) * 64, (v >> 3) * 64, 0, nullptr, tile); }
      else if (u < 1296) { const int v = u - 1168; transpose_tile(P.w_bs, 1024, LD5, (bf16_t*)(P.ws + OFF_WBS), (v & 7) * 64, (v >> 3) * 64, 0, nullptr, tile); }
      else if (u < 1424) { const int v = u - 1296; transpose_tile(P.w_ba, 1024, LD5, (bf16_t*)(P.ws + OFF_WBA), (v & 7) * 64, (v >> 3) * 64, 0, nullptr, tile); }
      else { const int v = u - 1424; transpose_tile(P.w_o, 1024, LDX, (bf16_t*)(P.ws + OFF_WO), (v & 15) * 64, (v >> 4) * 64, 0, nullptr, tile); }
    }
  }
  {
    bf16_t* X0 = (bf16_t*)(P.ws + OFF_X0);
    float2* STATS = (float2*)(P.ws + OFF_STATS);
    const int lane = tidx() & 63, gw = gt >> 6, nw = gs >> 6;
    for (int row0 = gw * 4; row0 < MT; row0 += nw * 4) {
      float4 v[4][4];
#pragma unroll
      for (int rr = 0; rr < 4; ++rr) {
        const int row = row0 + rr;
        const float* xr = row < 32768 ? P.x_prompt + (size_t)row * DM : P.x_sample + (size_t)(row - 32768) * DM;
#pragma unroll
        for (int i = 0; i < 4; ++i) v[rr][i] = *(const float4*)(xr + i * 256 + lane * 4);
      }
#pragma unroll
      for (int rr = 0; rr < 4; ++rr) {
        const int row = row0 + rr;
        float s = 0.f;
#pragma unroll
        for (int i = 0; i < 4; ++i) s += (v[rr][i].x + v[rr][i].y) + (v[rr][i].z + v[rr][i].w);
#pragma unroll
        for (int o = 32; o >= 1; o >>= 1) s += __shfl_xor(s, o);
        const float mu = s * (1.f / 1024.f);
        float q = 0.f;
#pragma unroll
        for (int i = 0; i < 4; ++i) { const float a = v[rr][i].x - mu, b = v[rr][i].y - mu, c = v[rr][i].z - mu, d = v[rr][i].w - mu; q += (a * a + b * b) + (c * c + d * d); }
#pragma unroll
        for (int o = 32; o >= 1; o >>= 1) q += __shfl_xor(q, o);
        const float rstd = rsqrtf(q * (1.f / 1024.f) + 1e-5f);
        if (lane == 0) STATS[row] = make_float2(mu, rstd);
#pragma unroll
        for (int i = 0; i < 4; ++i) {
          const int c = i * 256 + lane * 4;
          const float4 g = *(const float4*)(P.ln_in_g + c), b = *(const float4*)(P.ln_in_b + c);
          u32x2 o;
          o.x = pk2((v[rr][i].x - mu) * rstd * g.x + b.x, (v[rr][i].y - mu) * rstd * g.y + b.y);
          o.y = pk2((v[rr][i].z - mu) * rstd * g.z + b.z, (v[rr][i].w - mu) * rstd * g.w + b.w);
          *(u32x2*)(X0 + (size_t)row * LDX + c) = o;
        }
      }
    }
  }
}

DI void ph_g1(const Params& P, char* smem) {
  const int gt = blockIdx.x * blockDim.x + tidx(), gs = gridDim.x * blockDim.x;
  {
    const float* KT = (const float*)(P.ws + OFF_KT);
    bf16_t* WOUT = (bf16_t*)(P.ws + OFF_WOUT);
    for (int idx = gt; idx < 32 * 512 * 512; idx += gs) {
      const int k = idx & 511, tp = (idx >> 9) & 511, g = idx >> 18;
      const int q = k & 15, s = k >> 4, p = tp & 15, t = tp >> 4;
      float val;
      if (s < t) val = KT[(((g * 2 + 0) * 32 + (t - s)) * 16 + p) * 16 + q];
      else if (s > t) val = KT[(((g * 2 + 1) * 32 + (s - t)) * 16 + p) * 16 + q];
      else val = KT[(((g * 2 + 0) * 32) * 16 + p) * 16 + q] + KT[(((g * 2 + 1) * 32) * 16 + p) * 16 + q] + (p == q ? P.ssm_d[g * 16 + p] : 0.f);
#ifdef PROBE_NO_CONV
      val = (s == t && p == q) ? P.ssm_d[g * 16 + p] : 0.f;
#endif
      WOUT[((size_t)g * 512 + tp) * LDWO + k] = f2bf(val);
    }
  }
  const bf16_t* X0 = (const bf16_t*)(P.ws + OFF_X0);
  const bf16_t* W1T = (const bf16_t*)(P.ws + OFF_W1T);
  bf16_t* U = (bf16_t*)(P.ws + OFF_U);
  bf16_t* SZS = (bf16_t*)(P.ws + OFF_SZS);
  bf16_t* SZA = (bf16_t*)(P.ws + OFF_SZA);
  bf16_t* SGS = (bf16_t*)(P.ws + OFF_SGS);
  bf16_t* SGA = (bf16_t*)(P.ws + OFF_SGA);
  bf16_t* CQ = (bf16_t*)(P.ws + OFF_CQ);
  bf16_t* CKV = (bf16_t*)(P.ws + OFF_CKV);
  bf16_t* KR = (bf16_t*)(P.ws + OFF_KR);
  const float2* ROPE = (const float2*)(P.ws + OFF_ROPE);
  float* st = (float*)smem;
  for (int tile = blockIdx.x; tile < 256 * 16; tile += gridDim.x) {
    const int rnd = tile >> 8, bb = tile & 255, xcd = bb & 7, slot = bb >> 3;
    const int mt = (rnd & 7) * 32 + xcd * 4 + (slot & 3), nt = (rnd >> 3) * 8 + (slot >> 2), m0 = mt * 256, n0 = nt * 256;
    f32x4v acc[8][4];
    gemm_main<ARow, false>(acc, ARow{X0, LDX}, m0, W1T, LDX, n0, 1024, smem);
    if (nt < 2) {
      EPI_ALL({ const int col = n0 + lc0, tok = m0 + lrow; st8bf(U + ((size_t)(col >> 4) * NCH + (tok >> 5)) * LD5 + (tok & 31) * 16 + (col & 15), v); })
    } else if (nt < 4) {
      EPI_ALL({
        _Pragma("unroll") for (int j = 0; j < 8; ++j) v[j] = siluf_(v[j]);
        st8bf(SZS + (size_t)(m0 + lrow) * 512 + n0 - 512 + lc0, v); })
    } else if (nt == 4) {
      EPI_ALL({ st8bf(CQ + (size_t)(m0 + lrow) * LDQ + lc0, v); })
    } else if (nt == 5) {
      EPI_ALL({
        const int tok = m0 + lrow;
        if (lc0 < 128) st8bf(CKV + (size_t)tok * LDKV + lc0, v);
        else if (lc0 < 160) {
          const int c = lc0 - 128; const float2* cs = ROPE + tok_pos(tok) * 16 + (c & 15);
          float pv[8]; ld8(st + srow_ * STL + (lc0 ^ 16), pv);
          float o[8];
          _Pragma("unroll") for (int j = 0; j < 8; ++j) o[j] = c < 16 ? v[j] * cs[j].x - pv[j] * cs[j].y : pv[j] * cs[j].y + v[j] * cs[j].x;
          st8bf(KR + (size_t)tok * 32 + c, o);
        } })
    } else if (nt < 8) {
      EPI_ALL({
        _Pragma("unroll") for (int j = 0; j < 8; ++j) v[j] = siluf_(v[j]);
        st8bf(SZA + (size_t)(m0 + lrow) * 512 + n0 - 1536 + lc0, v); })
    } else if (nt < 12) {
      EPI_ALL({
        _Pragma("unroll") for (int j = 0; j < 8; ++j) v[j] = sigmoidf_(v[j]);
        st8bf(SGS + (size_t)(m0 + lrow) * 1024 + n0 - 2048 + lc0, v); })
    } else {
      EPI_ALL({
        _Pragma("unroll") for (int j = 0; j < 8; ++j) v[j] = sigmoidf_(v[j]);
        st8bf(SGA + (size_t)(m0 + lrow) * 1024 + n0 - 3072 + lc0, v); })
    }
  }
}

template <int KD> DI void row_rms_scale(const bf16_t* A, int lda, int m0, float mul, float* rssw) {
  const int row = tidx() >> 1, hf = tidx() & 1;
  const bf16_t* p = A + (size_t)(m0 + row) * lda + hf * (KD / 2);
  float ss = 0.f;
#pragma unroll
  for (int c = 0; c < KD / 16; ++c) {
    const u32x4 w = *(const u32x4*)(p + c * 8);
#pragma unroll
    for (int j = 0; j < 4; ++j) { const float lo = __uint_as_float(w[j] << 16), hi = __uint_as_float(w[j] & 0xffff0000u); ss += lo * lo + hi * hi; }
  }
  ss += __shfl_xor(ss, 1);
  if (hf == 0) rssw[row] = rsqrtf(ss * (1.f / KD) + 1e-6f) * mul;
}

constexpr int SH = 264;
DI void stage_tile_bf16(const f32x4v (&acc)[8][4], bf16_t* sth) {
  const int lane = tidx() & 63, wave = tidx() >> 6, wm = wave >> 2, wn = wave & 3, fr = lane & 15, fq = lane >> 4;
#pragma unroll
  for (int m = 0; m < 8; ++m)
#pragma unroll
    for (int n = 0; n < 4; ++n)
#pragma unroll
      for (int j = 0; j < 4; ++j) sth[(wm * 128 + m * 16 + fq * 4 + j) * SH + wn * 64 + n * 16 + fr] = f2bf(acc[m][n][j]);
  __syncthreads();
}

DI void ph_qkv(const Params& P, char* smem) {
  const bf16_t* CQ = (const bf16_t*)(P.ws + OFF_CQ);
  const bf16_t* CKV = (const bf16_t*)(P.ws + OFF_CKV);
  const bf16_t* KR = (const bf16_t*)(P.ws + OFF_KR);
  const bf16_t* U = (const bf16_t*)(P.ws + OFF_U);
  const float2* ROPE = (const float2*)(P.ws + OFF_ROPE);
  bf16_t* Q = (bf16_t*)((char*)P.out + OFF_Q);
  bf16_t* KM = (bf16_t*)((char*)P.out + OFF_K);
  bf16_t* VT = (bf16_t*)(P.ws + OFF_VT);
  float* S = (float*)(P.ws + OFF_S);
  float* rss = (float*)(smem + OFF_RSS);
  float* st = (float*)smem;
  bf16_t* sth = (bf16_t*)smem;
  for (int u = blockIdx.x; u < 768; u += gridDim.x) {
    const int nt = u % 3, mt = u / 3, m0 = mt * 256, n0 = nt * 256;
    f32x4v acc[8][4];
    row_rms_scale<256>(CQ, LDQ, m0, QSCALE, rss);
    gemm_main<ARow, false>(acc, ARow{CQ, LDQ}, m0, (const bf16_t*)(P.ws + OFF_WUQ), LDQ, n0, 256, smem);
    stage_tile_bf16(acc, sth);
#pragma unroll 1
    for (int it = 0; it < 16; ++it) {
      const int gid = it * NTHR + tidx(), lrow = gid >> 5, lc0 = (gid & 31) * 8;
      const int col = n0 + lc0, head = col / 96, c = col - head * 96, tok = m0 + lrow;
      const float sc = rss[lrow];
      float v[8], o[8];
      ld8bf(sth + lrow * SH + lc0, v);
      if (c >= 64) {
        const float2* cs = ROPE + tok_pos(tok) * 16 + (c & 15);
        float pv[8]; ld8bf(sth + lrow * SH + (lc0 ^ 16), pv);
#pragma unroll
        for (int j = 0; j < 8; ++j) o[j] = ((c & 16) ? pv[j] * cs[j].y + v[j] * cs[j].x : v[j] * cs[j].x - pv[j] * cs[j].y) * sc;
      } else {
#pragma unroll
        for (int j = 0; j < 8; ++j) o[j] = v[j] * sc;
      }
      st8bf(Q + ((size_t)head * MT + tok) * 96 + c, o);
    }
    __syncthreads();
  }
  for (int u = blockIdx.x; u < 1024; u += gridDim.x) {
    const int hp = u & 3, mt = u >> 2, m0 = mt * 256, n0 = hp * 256;
    f32x4v acc[8][4];
    row_rms_scale<128>(CKV, LDKV, m0, 1.f, rss);
    gemm_main<ARow, false>(acc, ARow{CKV, LDKV}, m0, (const bf16_t*)(P.ws + OFF_WUKV), LDKV, n0, 128, smem);
    stage_tile_bf16(acc, sth);
#pragma unroll 1
    for (int it = 0; it < 8; ++it) {
      const int gid = it * NTHR + tidx(), lrow = gid >> 4, cg = gid & 15, hl = cg >> 3, c0 = (cg & 7) * 8, tok = m0 + lrow;
      const float sc = rss[lrow];
      float v[8]; ld8bf(sth + lrow * SH + hl * 128 + c0, v);
#pragma unroll
      for (int j = 0; j < 8; ++j) v[j] *= sc;
      st8bf(KM + ((size_t)(hp * 2 + hl) * MT + tok) * 96 + c0, v);
    }
#pragma unroll 1
    for (int it = 0; it < 8; ++it) {
      const int gid = it * NTHR + tidx(), cv = gid >> 5, rg = (gid & 31) * 8, hl = cv >> 6, dv = cv & 63;
      float v[8];
#pragma unroll
      for (int j = 0; j < 8; ++j) v[j] = bf2f(sth[(rg + j) * SH + hl * 128 + 64 + dv]) * rss[rg + j];
      st8bf(VT + ((size_t)(hp * 2 + hl) * 64 + dv) * LDV + m0 + rg, v);
    }
    {
      const int tok = m0 + (tidx() >> 1), hf = tidx() & 1;
      const u32x4* sp = (const u32x4*)(KR + (size_t)tok * 32 + hf * 16);
      const u32x4 a = sp[0], b = sp[1];
#pragma unroll
      for (int hl = 0; hl < 2; ++hl) {
        u32x4* d = (u32x4*)(KM + ((size_t)(hp * 2 + hl) * MT + tok) * 96 + 64 + hf * 16);
        d[0] = a; d[1] = b;
      }
    }
    __syncthreads();
  }
  for (int u = blockIdx.x; u < 256; u += gridDim.x) {
    const int mt = u & 7, g = u >> 3, m0 = mt * 256;
    f32x4v acc[8][4];
    gemm_main<ARow, false>(acc, ARow{U + (size_t)g * NCH * LD5, LD5}, m0, (const bf16_t*)(P.ws + OFF_WST) + (size_t)g * 256 * LD5, LD5, 0, 512, smem);
    EPI_ALL({
      float* d = S + ((size_t)g * NCH + m0 + lrow) * 256 + lc0;
      *(float4*)d = make_float4(v[0], v[1], v[2], v[3]); *(float4*)(d + 4) = make_float4(v[4], v[5], v[6], v[7]); })
  }
}

DI void ph_scan(const Params& P, char* smem) {
  const float* S = (const float*)(P.ws + OFF_S);
  bf16_t* HST = (bf16_t*)(P.ws + OFF_HST);
  const float2* LP = (const float2*)(P.ws + OFF_LP);
  float2* E = (float2*)smem;
  const int n = tidx() & 63, sg = tidx() >> 6;
  for (int job = blockIdx.x; job < 384; job += gridDim.x) {
    const int dir = job & 1, g = (job >> 1) & 31, seq = job >> 6;
    const int c0 = seq < 2 ? seq * 512 : 1024 + (seq - 2) * 256, nc = seq < 2 ? 512 : 256, segl = nc >> 3;
    const float2 a = LP[((g * 2 + dir) * 33 + 32) * 64 + n];
    const float* Sg = S + (size_t)g * NCH * 256 + dir * 128 + n;
    bf16_t* Hg = HST + (size_t)g * NCH * LDQ + dir * 128 + n;
    const int j0 = sg * segl;
    float hr = 0.f, hi = 0.f;
    for (int jb = 0; jb < segl; jb += 32) {
      float sr[32], si[32];
#pragma unroll
      for (int j = 0; j < 32; ++j) { const int jj = j0 + jb + j, c = dir ? (c0 + nc - 1 - jj) : (c0 + jj); sr[j] = Sg[(size_t)c * 256]; si[j] = Sg[(size_t)c * 256 + 64]; }
#pragma unroll
      for (int j = 0; j < 32; ++j) { const float nr = a.x * hr - a.y * hi + sr[j], ni = a.x * hi + a.y * hr + si[j]; hr = nr; hi = ni; }
    }
    E[sg * 64 + n] = make_float2(hr, hi);
    float pr = a.x, pi = a.y;
    for (int q = segl; q > 1; q >>= 1) { const float nr = pr * pr - pi * pi, ni = 2.f * pr * pi; pr = nr; pi = ni; }
    __syncthreads();
    hr = 0.f; hi = 0.f;
    for (int t = 0; t < sg; ++t) { const float2 e = E[t * 64 + n]; const float nr = pr * hr - pi * hi + e.x, ni = pr * hi + pi * hr + e.y; hr = nr; hi = ni; }
    for (int jb = 0; jb < segl; jb += 32) {
      float sr[32], si[32];
#pragma unroll
      for (int j = 0; j < 32; ++j) { const int jj = j0 + jb + j, c = dir ? (c0 + nc - 1 - jj) : (c0 + jj); sr[j] = Sg[(size_t)c * 256]; si[j] = Sg[(size_t)c * 256 + 64]; }
#pragma unroll
      for (int j = 0; j < 32; ++j) {
        const int jj = j0 + jb + j, c = dir ? (c0 + nc - 1 - jj) : (c0 + jj);
        Hg[(size_t)c * LDQ] = f2bf(hr); Hg[(size_t)c * LDQ + 64] = f2bf(hi);
        const float nr = a.x * hr - a.y * hi + sr[j], ni = a.x * hi + a.y * hr + si[j]; hr = nr; hi = ni;
      }
    }
    __syncthreads();
  }
}

DI void attn_unit(const Params& P, int tok0, int L, int head, int q0, char* smem) {
  const int tid = tidx(), lane = tid & 63, wave = tid >> 6, r = lane & 31, h = lane >> 5;
  const bf16_t* Qh = (const bf16_t*)((char*)P.out + OFF_Q) + (size_t)head * MT * 96;
  const bf16_t* Kh = (const bf16_t*)((char*)P.out + OFF_K) + ((size_t)head * MT + tok0) * 96;
  const bf16_t* Vh = (const bf16_t*)(P.ws + OFF_VT) + (size_t)head * 64 * LDV + tok0;
  const bf16_t* SZA = (const bf16_t*)(P.ws + OFF_SZA);
  bf16_t* YA = (bf16_t*)(P.ws + OFF_YA);
  const int qtok = tok0 + q0 + wave * 32 + r;
  bf16x8 qf[6];
#pragma unroll
  for (int ks = 0; ks < 6; ++ks) qf[ks] = *(const bf16x8*)(Qh + (size_t)qtok * 96 + ks * 16 + h * 8);
  f32x16 O[2];
  f32x16 negm;
#pragma unroll
  for (int i = 0; i < 16; ++i) { O[0][i] = 0.f; O[1][i] = 0.f; negm[i] = 0.f; }
  float l = 0.f;
  constexpr int KSTR = 208, VSTR = 264, KBYTES = 128 * KSTR, STG = KBYTES + 64 * VSTR;
  u32x4 rk[3], rv[2];
  int kgo[3], klo[3];
#pragma unroll
  for (int i = 0; i < 3; ++i) { const int id = tid + 512 * i, kr = id / 12, kc = id - kr * 12; kgo[i] = kr * 96 + kc * 8; klo[i] = kr * KSTR + kc * 16; }
  const int vrow = tid >> 4, vch = tid & 15;
  const int nkt = L >> 7;
#define KV_LOAD(KT)                                                                                               \
  { const int key0_ = (KT) * 128;                                                                                 \
    _Pragma("unroll") for (int i = 0; i < 3; ++i) rk[i] = *(const u32x4*)(Kh + (size_t)key0_ * 96 + kgo[i]);      \
    _Pragma("unroll") for (int i = 0; i < 2; ++i) rv[i] = *(const u32x4*)(Vh + (size_t)(vrow + 32 * i) * LDV + key0_ + vch * 8); }
#define KV_WRITE(BUF)                                                                                             \
  { char* sk_ = smem + (BUF) * STG; char* sv_ = sk_ + KBYTES;                                                     \
    _Pragma("unroll") for (int i = 0; i < 3; ++i) *(u32x4*)(sk_ + klo[i]) = rk[i];                                \
    _Pragma("unroll") for (int i = 0; i < 2; ++i) { char* d = sv_ + (vrow + 32 * i) * VSTR + vch * 16;            \
      *(u32x2*)d = (u32x2){rv[i].x, rv[i].y}; *(u32x2*)(d + 8) = (u32x2){rv[i].z, rv[i].w}; } }
  KV_LOAD(0)
  KV_WRITE(0)
  if (1 < nkt) KV_LOAD(1)
  for (int kt = 0; kt < nkt; ++kt) {
    char* sk0 = smem + (kt & 1) * STG;
    char* sv0 = sk0 + KBYTES;
    __syncthreads();
    __builtin_amdgcn_sched_barrier(0);
    f32x16 S[2][2];
#pragma unroll
    for (int hf = 0; hf < 2; ++hf)
#pragma unroll
      for (int kb = 0; kb < 2; ++kb) {
#pragma unroll
        for (int ks = 0; ks < 6; ++ks) {
          const bf16x8 kf = *(const bf16x8*)(sk0 + (hf * 64 + kb * 32 + r) * KSTR + (ks * 2 + h) * 16);
          S[hf][kb] = __builtin_amdgcn_mfma_f32_32x32x16_bf16(kf, qf[ks], ks == 0 ? negm : S[hf][kb], 0, 0, 0);
        }
      }
    __builtin_amdgcn_sched_barrier(0);
    if (kt + 1 < nkt) { char* sv_ = smem + ((kt + 1) & 1) * STG + KBYTES;
      _Pragma("unroll") for (int i = 0; i < 2; ++i) { char* d = sv_ + (vrow + 32 * i) * VSTR + vch * 16;
        *(u32x2*)d = (u32x2){rv[i].x, rv[i].y}; *(u32x2*)(d + 8) = (u32x2){rv[i].z, rv[i].w}; } }
    if (kt + 2 < nkt) { const int key0_ = (kt + 2) * 128;
      _Pragma("unroll") for (int i = 0; i < 2; ++i) rv[i] = *(const u32x4*)(Vh + (size_t)(vrow + 32 * i) * LDV + key0_ + vch * 8); }
    __builtin_amdgcn_sched_barrier(0);
    float mx = fmaxf(fmaxf(S[0][0][0], S[0][0][1]), S[0][0][2]);
#pragma unroll
    for (int i = 3; i < 15; i += 2) mx = fmaxf(fmaxf(mx, S[0][0][i]), S[0][0][i + 1]);
    mx = fmaxf(mx, S[0][0][15]);
#pragma unroll
    for (int i = 0; i < 16; i += 2) mx = fmaxf(fmaxf(mx, S[0][1][i]), S[0][1][i + 1]);
#pragma unroll
    for (int i = 0; i < 16; i += 2) mx = fmaxf(fmaxf(mx, S[1][0][i]), S[1][0][i + 1]);
#pragma unroll
    for (int i = 0; i < 16; i += 2) mx = fmaxf(fmaxf(mx, S[1][1][i]), S[1][1][i + 1]);
    if (kt == 0 || __any(mx > 8.f)) {
      const float mxf = fmaxf(mx, __shfl_xor(mx, 32));
      const float delta = kt == 0 ? mxf : fmaxf(mxf, 0.f);
      const float alpha = kt == 0 ? 1.f : __builtin_amdgcn_exp2f(-delta);
      l *= alpha;
      const float nm = negm[0] - delta;
#pragma unroll
      for (int i = 0; i < 16; ++i) {
        O[0][i] *= alpha; O[1][i] *= alpha; negm[i] = nm;
        S[0][0][i] -= delta; S[0][1][i] -= delta; S[1][0][i] -= delta; S[1][1][i] -= delta;
      }
    }
    float ps = 0.f;
    bf16x8 pf[2][2][2];
#pragma unroll
    for (int hf = 0; hf < 2; ++hf) {
#pragma unroll
      for (int kb = 0; kb < 2; ++kb)
#pragma unroll
        for (int i = 0; i < 16; ++i) { S[hf][kb][i] = __builtin_amdgcn_exp2f(S[hf][kb][i]); ps += S[hf][kb][i]; }
#pragma unroll
      for (int kb = 0; kb < 2; ++kb)
#pragma unroll
        for (int s2 = 0; s2 < 2; ++s2) {
          u32x4 w;
          w.x = pk2(S[hf][kb][8 * s2 + 0], S[hf][kb][8 * s2 + 1]); w.y = pk2(S[hf][kb][8 * s2 + 2], S[hf][kb][8 * s2 + 3]);
          w.z = pk2(S[hf][kb][8 * s2 + 4], S[hf][kb][8 * s2 + 5]); w.w = pk2(S[hf][kb][8 * s2 + 6], S[hf][kb][8 * s2 + 7]);
          pf[hf][kb][s2] = __builtin_bit_cast(bf16x8, w);
        }
    }
    l += ps;
    __builtin_amdgcn_sched_barrier(0);
    if (kt + 1 < nkt) { char* sk_ = smem + ((kt + 1) & 1) * STG;
      _Pragma("unroll") for (int i = 0; i < 3; ++i) *(u32x4*)(sk_ + klo[i]) = rk[i]; }
    if (kt + 2 < nkt) { const int key0_ = (kt + 2) * 128;
      _Pragma("unroll") for (int i = 0; i < 3; ++i) rk[i] = *(const u32x4*)(Kh + (size_t)key0_ * 96 + kgo[i]); }
    __builtin_amdgcn_sched_barrier(0);
#pragma unroll
    for (int hf = 0; hf < 2; ++hf)
#pragma unroll
      for (int db = 0; db < 2; ++db)
#pragma unroll
        for (int kb = 0; kb < 2; ++kb)
#pragma unroll
          for (int s2 = 0; s2 < 2; ++s2) {
            const char* a = sv0 + hf * 128 + (db * 32 + r) * VSTR + (kb * 32 + s2 * 16 + h * 4) * 2;
            const u32x2 lo = *(const u32x2*)a, hi = *(const u32x2*)(a + 16);
            const u32x4 w = {lo.x, lo.y, hi.x, hi.y};
            O[db] = __builtin_amdgcn_mfma_f32_32x32x16_bf16(__builtin_bit_cast(bf16x8, w), pf[hf][kb][s2], O[db], 0, 0, 0);
          }
  }
#undef KV_LOAD
#undef KV_WRITE
  __syncthreads();
  l += __shfl_xor(l, 32);
  const float inv = 1.f / l;
#pragma unroll
  for (int db = 0; db < 2; ++db)
#pragma unroll
    for (int g4 = 0; g4 < 4; ++g4) {
      const size_t o = (size_t)qtok * 512 + head * 64 + db * 32 + 8 * g4 + 4 * h, oy = (size_t)qtok * LD5 + head * 64 + db * 32 + 8 * g4 + 4 * h;
      const u32x2 gz = *(const u32x2*)(SZA + o);
      const float g0 = __uint_as_float(gz.x << 16), g1 = __uint_as_float(gz.x & 0xffff0000u), g2 = __uint_as_float(gz.y << 16), g3 = __uint_as_float(gz.y & 0xffff0000u);
      u32x2 w;
      w.x = pk2(O[db][4 * g4 + 0] * inv * g0, O[db][4 * g4 + 1] * inv * g1);
      w.y = pk2(O[db][4 * g4 + 2] * inv * g2, O[db][4 * g4 + 3] * inv * g3);
#ifdef PROBE_NO_ATTN
      w.x = 0; w.y = 0;
#endif
      *(u32x2*)(YA + oy) = w;
    }
}

DI void ph_mix(const Params& P, char* smem) {
  const bf16_t* U = (const bf16_t*)(P.ws + OFF_U);
  const bf16_t* HST = (const bf16_t*)(P.ws + OFF_HST);
  bf16_t* Y = (bf16_t*)(P.ws + OFF_S);
  float* st = (float*)smem;
  const int NU = 512 + 2048;
  for (int u = blockIdx.x; u < NU; u += gridDim.x) {
    if (u < 512) {
      const int nt = u & 1, mt = (u >> 1) & 7, g = u >> 4, m0 = mt * 256, n0 = nt * 256;
      f32x4v acc[8][4];
      gemm_main<ATwo, false>(acc, ATwo{U + (size_t)g * NCH * LD5, LD5, 64, HST + (size_t)g * NCH * LDQ, LDQ}, m0,
                             (const bf16_t*)(P.ws + OFF_WOUT) + (size_t)g * 512 * LDWO, LDWO, n0, 768, smem);
      EPI_ALL({
        _Pragma("unroll") for (int j = 0; j < 8; ++j) v[j] = geluf_(v[j]);
        st8bf(Y + ((size_t)g * NCH + m0 + lrow) * 512 + n0 + lc0, v); })
    } else {
      const int v2 = u - 512;
      const int head = v2 & 7, w = v2 >> 3;
      int tok0, L, qb;
      if (w < 128) { const int seq = w >> 6; qb = w & 63; tok0 = seq * 16384; L = 16384; }
      else { const int w2 = w - 128; const int seq = w2 >> 5; qb = w2 & 31; tok0 = 32768 + seq * 8192; L = 8192; }
      attn_unit(P, tok0, L, head, qb * 256, smem);
    }
  }
}

DI void ph_glu(const Params& P, char* smem) {
  const bf16_t* Y = (const bf16_t*)(P.ws + OFF_S);
  const bf16_t* SZS = (const bf16_t*)(P.ws + OFF_SZS);
  bf16_t* YS = (bf16_t*)(P.ws + OFF_U);
  float* st = (float*)smem;
  for (int u = blockIdx.x; u < 512; u += gridDim.x) {
    const int rnd = u >> 8, bb = u & 255, xcd = bb & 7, slot = bb >> 3;
    const int mt = rnd * 128 + xcd * 16 + (slot & 15), nt = slot >> 4, m0 = mt * 256, n0 = nt * 256;
    f32x4v acc[8][4];
    gemm_main<AGrp, false>(acc, AGrp{Y}, m0, (const bf16_t*)(P.ws + OFF_WGLU), LD5, n0, 512, smem);
    EPI_ALL({
      const int col = n0 + lc0, tok = m0 + lrow;
      float y[8], z[8], o[8];
      ld8bf(Y + ((size_t)(col >> 4) * MT + tok) * 16 + (col & 15), y);
      ld8bf(SZS + (size_t)tok * 512 + col, z);
      _Pragma("unroll") for (int j = 0; j < 8; ++j) o[j] = y[j] * sigmoidf_(v[j] + P.b_glu[col + j]) * z[j];
      st8bf(YS + (size_t)tok * LD5 + col, o); })
  }
}

DI void ph_merge(const Params& P, char* smem) {
  const bf16_t* YS = (const bf16_t*)(P.ws + OFF_U);
  const bf16_t* YA = (const bf16_t*)(P.ws + OFF_YA);
  const bf16_t* SGS = (const bf16_t*)(P.ws + OFF_SGS);
  const bf16_t* SGA = (const bf16_t*)(P.ws + OFF_SGA);
  bf16_t* MG = (bf16_t*)(P.ws + OFF_X0);
  float* st = (float*)smem;
  for (int u = blockIdx.x; u < 1024; u += gridDim.x) {
    const int rnd = u >> 8, bb = u & 255, xcd = bb & 7, slot = bb >> 3;
    const int mt = rnd * 64 + xcd * 8 + (slot & 7), nt = slot >> 3, m0 = mt * 256, n0 = nt * 256;
    f32x4v acc[8][4];
#pragma unroll 1
    for (int pass = 0; pass < 2; ++pass) {
      const bf16_t* A = pass ? YA : YS;
      const bf16_t* B = (const bf16_t*)(P.ws + (pass ? OFF_WBA : OFF_WBS));
      const bf16_t* G = pass ? SGA : SGS;
      gemm_main<ARow, false>(acc, ARow{A, LD5}, m0, B, LD5, n0, 512, smem);
      EPI_ALL({
        const size_t og = (size_t)(m0 + lrow) * 1024 + n0 + lc0, o = (size_t)(m0 + lrow) * LDX + n0 + lc0;
        float gte[8]; ld8bf(G + og, gte);
        _Pragma("unroll") for (int j = 0; j < 8; ++j) v[j] *= gte[j];
        if (pass) {
          float pr[8]; ld8bf(MG + o, pr);
          _Pragma("unroll") for (int j = 0; j < 8; ++j) v[j] += pr[j];
        }
        st8bf(MG + o, v); })
    }
  }
}

DI void wg_drain() {
  asm volatile("s_waitcnt vmcnt(0)" ::: "memory");
  __syncthreads();
  __builtin_amdgcn_fence(__ATOMIC_ACQUIRE, "agent");
  asm volatile("s_waitcnt vmcnt(0)" ::: "memory");
}
DI void ph_out(const Params& P, char* smem) {
  const bf16_t* MG = (const bf16_t*)(P.ws + OFF_X0);
  const float2* STATS = (const float2*)(P.ws + OFF_STATS);
  float* st = (float*)smem;
  for (int mt = blockIdx.x; mt < 256; mt += gridDim.x) {
    const int m0 = mt * 256;
#pragma unroll 1
    for (int nt = 0; nt < 4; ++nt) {
      const int n0 = nt * 256;
      f32x4v acc[8][4];
      gemm_main<ARow, false>(acc, ARow{MG, LDX}, m0, (const bf16_t*)(P.ws + OFF_WO), LDX, n0, 1024, smem);
      EPI_ALL({
        const int tok = m0 + lrow, col = n0 + lc0;
        const float* xp = tok < 32768 ? P.x_prompt + (size_t)tok * DM + col : P.x_sample + (size_t)(tok - 32768) * DM + col;
        float xv[8], gg[8], bb[8];
        ld8(xp, xv); ld8(P.ln_in_g + col, gg); ld8(P.ln_in_b + col, bb);
        const float2 stt = STATS[tok];
        _Pragma("unroll") for (int j = 0; j < 8; ++j) v[j] += ALPHA_RES * ((xv[j] - stt.x) * stt.y * gg[j] + bb[j]);
        float* d = P.out + (size_t)tok * DM + col;
        *(float4*)d = make_float4(v[0], v[1], v[2], v[3]); *(float4*)(d + 4) = make_float4(v[4], v[5], v[6], v[7]); })
    }
    wg_drain();
    {
      const int lane = tidx() & 63, wave = tidx() >> 6;
#pragma unroll 1
      for (int rs = 0; rs < 32; rs += 4) {
        const int row0 = m0 + wave * 32 + rs;
        float4 v[4][4];
#pragma unroll
        for (int rr = 0; rr < 4; ++rr)
#pragma unroll
          for (int i = 0; i < 4; ++i) v[rr][i] = *(const float4*)(P.out + (size_t)(row0 + rr) * DM + i * 256 + lane * 4);
#pragma unroll
        for (int rr = 0; rr < 4; ++rr) {
          float* zr = P.out + (size_t)(row0 + rr) * DM;
          float s = 0.f;
#pragma unroll
          for (int i = 0; i < 4; ++i) s += (v[rr][i].x + v[rr][i].y) + (v[rr][i].z + v[rr][i].w);
#pragma unroll
          for (int o = 32; o >= 1; o >>= 1) s += __shfl_xor(s, o);
          const float mu = s * (1.f / 1024.f);
          float q = 0.f;
#pragma unroll
          for (int i = 0; i < 4; ++i) { const float a = v[rr][i].x - mu, b = v[rr][i].y - mu, c = v[rr][i].z - mu, d = v[rr][i].w - mu; q += (a * a + b * b) + (c * c + d * d); }
#pragma unroll
          for (int o = 32; o >= 1; o >>= 1) q += __shfl_xor(q, o);
          const float rstd = rsqrtf(q * (1.f / 1024.f) + 1e-5f);
#pragma unroll
          for (int i = 0; i < 4; ++i) {
            const int c = i * 256 + lane * 4;
            const float4 g = *(const float4*)(P.ln_g + c), b = *(const float4*)(P.ln_b + c);
            float4 o;
            o.x = (v[rr][i].x - mu) * rstd * g.x + b.x; o.y = (v[rr][i].y - mu) * rstd * g.y + b.y;
            o.z = (v[rr][i].z - mu) * rstd * g.z + b.z; o.w = (v[rr][i].w - mu) * rstd * g.w + b.w;
            *(float4*)(zr + c) = o;
          }
        }
      }
    }
    __syncthreads();
  }
}

DI void ph_final_ln(const Params& P) {
  const int gt = blockIdx.x * blockDim.x + tidx(), gs = gridDim.x * blockDim.x;
  const int lane = tidx() & 63, gw = gt >> 6, nw = gs >> 6;
  for (int row0 = gw * 4; row0 < MT; row0 += nw * 4) {
    float4 v[4][4];
#pragma unroll
    for (int rr = 0; rr < 4; ++rr)
#pragma unroll
      for (int i = 0; i < 4; ++i) v[rr][i] = *(const float4*)(P.out + (size_t)(row0 + rr) * DM + i * 256 + lane * 4);
#pragma unroll
    for (int rr = 0; rr < 4; ++rr) {
      float* zr = P.out + (size_t)(row0 + rr) * DM;
      float s = 0.f;
#pragma unroll
      for (int i = 0; i < 4; ++i) s += (v[rr][i].x + v[rr][i].y) + (v[rr][i].z + v[rr][i].w);
#pragma unroll
      for (int o = 32; o >= 1; o >>= 1) s += __shfl_xor(s, o);
      const float mu = s * (1.f / 1024.f);
      float q = 0.f;
#pragma unroll
      for (int i = 0; i < 4; ++i) { const float a = v[rr][i].x - mu, b = v[rr][i].y - mu, c = v[rr][i].z - mu, d = v[rr][i].w - mu; q += (a * a + b * b) + (c * c + d * d); }
#pragma unroll
      for (int o = 32; o >= 1; o >>= 1) q += __shfl_xor(q, o);
      const float rstd = rsqrtf(q * (1.f / 1024.f) + 1e-5f);
#pragma unroll
      for (int i = 0; i < 4; ++i) {
        const int c = i * 256 + lane * 4;
        const float4 g = *(const float4*)(P.ln_g + c), b = *(const float4*)(P.ln_b + c);
        float4 o;
        o.x = (v[rr][i].x - mu) * rstd * g.x + b.x; o.y = (v[rr][i].y - mu) * rstd * g.y + b.y;
        o.z = (v[rr][i].z - mu) * rstd * g.z + b.z; o.w = (v[rr][i].w - mu) * rstd * g.w + b.w;
        *(float4*)(zr + c) = o;
      }
    }
  }
}

#define XB_TMO      128
#define XB_XCNT(j)  (256  + 64 * (j))
#define XB_XSUB(j)  (1280 + 64 * (j))
#define XB_XGEN(j)  (2304 + 64 * (j))
#define XB_TOP      3328
#define XB_TOPGEN   3392
#define XCD_BAR_WORDS 3456
#define XB_SPIN_CAP (1u << 22)
#define LAS __attribute__((address_space(3)))
DI unsigned xb_ld(unsigned* p) { return __hip_atomic_load(p, __ATOMIC_RELAXED, __HIP_MEMORY_SCOPE_AGENT); }
DI unsigned xb_add(unsigned* p, unsigned v) { return __hip_atomic_fetch_add(p, v, __ATOMIC_RELAXED, __HIP_MEMORY_SCOPE_AGENT); }
DI unsigned xb_xcc_id() { return (unsigned)__builtin_amdgcn_s_getreg((3 << 11) | 20) & 0xFu; }
#define XB_SPIN(cond, bar) do { unsigned _sp = 0; while (cond) { __builtin_amdgcn_s_sleep(1); \
    if ((++_sp & 255u) == 0u) { if (xb_ld(&(bar)[XB_TMO])) break; if (_sp > XB_SPIN_CAP) { atomicAdd(&(bar)[XB_TMO], 1u); break; } } } } while (0)
struct XcdBarrier { unsigned* bar; unsigned x; volatile LAS unsigned* st; };
DI XcdBarrier xcd_barrier_post(unsigned* bar, volatile LAS unsigned* st) {
  XcdBarrier b; b.bar = bar; b.x = xb_xcc_id(); b.st = st;
  if (threadIdx.x == 0) (void)xb_add(&bar[XB_XCNT(b.x)], 1u);
  return b;
}
DI void xcd_barrier_complete(unsigned* bar, unsigned x, unsigned& nloc, unsigned& nx) {
  const unsigned G = gridDim.x * gridDim.y * gridDim.z;
  unsigned sum, cnt, mine, sp = 0u;
  for (;;) {
    sum = 0u; cnt = 0u; mine = 0u;
#pragma unroll
    for (unsigned j = 0; j < 16; ++j) { const unsigned c = xb_ld(&bar[XB_XCNT(j)]); sum += c; cnt += (c > 0u) ? 1u : 0u; mine = (j == x) ? c : mine; }
    if (sum == G) break;
    __builtin_amdgcn_s_sleep(1);
    if ((++sp & 255u) == 0u) { if (xb_ld(&bar[XB_TMO])) break; if (sp > XB_SPIN_CAP) { atomicAdd(&bar[XB_TMO], 1u); break; } }
  }
  nloc = mine > 0u ? mine : 1u; nx = cnt > 0u ? cnt : 1u;
}
DI void xcd_barrier(const XcdBarrier& b) {
  asm volatile("s_waitcnt vmcnt(0)" ::: "memory");
  __syncthreads();
  if (threadIdx.x == 0) {
    unsigned* bar = b.bar;
    __builtin_amdgcn_s_waitcnt(0);
    unsigned nloc = b.st[0], nx = b.st[1];
    if (nloc == 0u) { xcd_barrier_complete(bar, b.x, nloc, nx); b.st[0] = nloc; b.st[1] = nx; }
    const unsigned old = xb_add(&bar[XB_XSUB(b.x)], 1u);
    const unsigned gen = old / nloc;
    if (old + 1u == (gen + 1u) * nloc) {
      __builtin_amdgcn_fence(__ATOMIC_RELEASE, "agent");
      asm volatile("s_waitcnt vmcnt(0)" ::: "memory");
      const unsigned og = xb_add(&bar[XB_TOP], 1u);
      const unsigned tg = og / nx;
      if (og + 1u == (tg + 1u) * nx) xb_add(&bar[XB_TOPGEN], 1u);
      else XB_SPIN(xb_ld(&bar[XB_TOPGEN]) == tg, bar);
      __builtin_amdgcn_fence(__ATOMIC_ACQUIRE, "agent");
      xb_add(&bar[XB_XGEN(b.x)], 1u);
      asm volatile("s_waitcnt vmcnt(0)" ::: "memory");
    } else {
      XB_SPIN(xb_ld(&bar[XB_XGEN(b.x)]) == gen, bar);
      __builtin_amdgcn_fence(__ATOMIC_ACQUIRE, "agent");
      asm volatile("s_waitcnt vmcnt(0)" ::: "memory");
    }
  }
  __syncthreads();
}

#ifndef N_LAUNCH_MODE
#define N_LAUNCH_MODE 1
#endif

template <int PH> DI void run_phase(const Params& P, char* smem) {
  if (PH == 0) ph_tables(P);
  else if (PH == 1) ph_prep(P, smem);
  else if (PH == 2) ph_g1(P, smem);
  else if (PH == 3) ph_qkv(P, smem);
  else if (PH == 4) ph_scan(P, smem);
  else if (PH == 5) ph_mix(P, smem);
  else if (PH == 6) ph_glu(P, smem);
  else if (PH == 7) ph_merge(P, smem);
  else if (PH == 8) ph_out(P, smem);
  else { }
}

#if N_LAUNCH_MODE == 1
__global__ void __launch_bounds__(512, 2) fwd_kernel(Params P_arg) {
  __shared__ __attribute__((aligned(1024))) char smem[SMEM_BYTES];
  cg::grid_group grid = cg::this_grid();
  const Params& P = *(const Params*)__builtin_amdgcn_kernarg_segment_ptr();
  if (threadIdx.x == 0) *(uint4*)(smem + OFF_XBW) = make_uint4(0u, 0u, 0u, 0u);
  __syncthreads();
  const XcdBarrier xb = xcd_barrier_post((unsigned*)(P.ws + OFF_BAR), (volatile LAS unsigned*)(smem + OFF_XBW));
  if (P.pad0 == 0x7fffffff) grid.sync();
#if defined(SPIN_PHASE) && SPIN_PHASE == 0
  { const unsigned long long t0_ = wall_clock64();
  run_phase<0>(P, smem);
  const unsigned long long t1_ = wall_clock64(); while (wall_clock64() - t1_ < t1_ - t0_) __builtin_amdgcn_s_sleep(8); }
#else
  run_phase<0>(P, smem);
#endif
  xcd_barrier(xb);
#if defined(SPIN_PHASE) && SPIN_PHASE == 1
  { const unsigned long long t0_ = wall_clock64();
  run_phase<1>(P, smem);
  const unsigned long long t1_ = wall_clock64(); while (wall_clock64() - t1_ < t1_ - t0_) __builtin_amdgcn_s_sleep(8); }
#else
  run_phase<1>(P, smem);
#endif
  xcd_barrier(xb);
#if defined(SPIN_PHASE) && SPIN_PHASE == 2
  { const unsigned long long t0_ = wall_clock64();
  run_phase<2>(P, smem);
  const unsigned long long t1_ = wall_clock64(); while (wall_clock64() - t1_ < t1_ - t0_) __builtin_amdgcn_s_sleep(8); }
#else
  run_phase<2>(P, smem);
#endif
  xcd_barrier(xb);
#if defined(SPIN_PHASE) && SPIN_PHASE == 3
  { const unsigned long long t0_ = wall_clock64();
  run_phase<3>(P, smem);
  const unsigned long long t1_ = wall_clock64(); while (wall_clock64() - t1_ < t1_ - t0_) __builtin_amdgcn_s_sleep(8); }
#else
  run_phase<3>(P, smem);
#endif
  xcd_barrier(xb);
#if defined(SPIN_PHASE) && SPIN_PHASE == 4
  { const unsigned long long t0_ = wall_clock64();
  run_phase<4>(P, smem);
  const unsigned long long t1_ = wall_clock64(); while (wall_clock64() - t1_ < t1_ - t0_) __builtin_amdgcn_s_sleep(8); }
#else
  run_phase<4>(P, smem);
#endif
  xcd_barrier(xb);
#if defined(SPIN_PHASE) && SPIN_PHASE == 5
  { const unsigned long long t0_ = wall_clock64();
  run_phase<5>(P, smem);
  const unsigned long long t1_ = wall_clock64(); while (wall_clock64() - t1_ < t1_ - t0_) __builtin_amdgcn_s_sleep(8); }
#else
  run_phase<5>(P, smem);
#endif
  xcd_barrier(xb);
#if defined(SPIN_PHASE) && SPIN_PHASE == 6
  { const unsigned long long t0_ = wall_clock64();
  run_phase<6>(P, smem);
  const unsigned long long t1_ = wall_clock64(); while (wall_clock64() - t1_ < t1_ - t0_) __builtin_amdgcn_s_sleep(8); }
#else
  run_phase<6>(P, smem);
#endif
  xcd_barrier(xb);
#if defined(SPIN_PHASE) && SPIN_PHASE == 7
  { const unsigned long long t0_ = wall_clock64();
  run_phase<7>(P, smem);
  const unsigned long long t1_ = wall_clock64(); while (wall_clock64() - t1_ < t1_ - t0_) __builtin_amdgcn_s_sleep(8); }
#else
  run_phase<7>(P, smem);
#endif
  xcd_barrier(xb);
#if defined(SPIN_PHASE) && SPIN_PHASE == 8
  { const unsigned long long t0_ = wall_clock64();
  run_phase<8>(P, smem);
  const unsigned long long t1_ = wall_clock64(); while (wall_clock64() - t1_ < t1_ - t0_) __builtin_amdgcn_s_sleep(8); }
#else
  run_phase<8>(P, smem);
#endif
}
#else
template <int PH> __global__ void __launch_bounds__(512, 2) phase_kernel(Params P) {
  __shared__ __attribute__((aligned(1024))) char smem[SMEM_BYTES];
  run_phase<PH>(P, smem);
}
#endif

extern "C" void kernel_launch(void* const* d_in, const int* in_sizes, int n_in, void* d_out, int out_size, void* d_ws, size_t ws_size, hipStream_t stream) {
  if (ws_size < WS_NEEDED) { fprintf(stderr, "workspace too small: %zu < %zu\n", ws_size, WS_NEEDED); return; }
  Params p{};
  const float** f = (const float**)&p;
  for (int i = 0; i < 29; ++i) f[i] = (const float*)d_in[i];
  p.out = (float*)d_out;
  p.ws = (char*)d_ws;
  static int grid_blocks = 0;
#if N_LAUNCH_MODE == 1
  if (!grid_blocks) {
    int dev = 0, cus = 0, per_cu = 0;
    (void)hipGetDevice(&dev);
    (void)hipDeviceGetAttribute(&cus, hipDeviceAttributeMultiprocessorCount, dev);
    (void)hipOccupancyMaxActiveBlocksPerMultiprocessor(&per_cu, fwd_kernel, NTHR, 0);
    if (per_cu > 1) per_cu = 1;
    if (per_cu < 1) per_cu = 1;
    grid_blocks = cus * per_cu;
  }
  (void)hipMemsetAsync((char*)d_ws + OFF_BAR, 0, XCD_BAR_WORDS * sizeof(unsigned), stream);
  void* args[] = {&p};
  hipError_t e = hipLaunchCooperativeKernel((void*)fwd_kernel, dim3(grid_blocks), dim3(NTHR), args, 0, stream);
  if (e != hipSuccess) fprintf(stderr, "cooperative launch failed: %s (grid %d)\n", hipGetErrorString(e), grid_blocks);
#else
  grid_blocks = 256;
  hipLaunchKernelGGL(phase_kernel<0>, dim3(grid_blocks), dim3(NTHR), 0, stream, p);
#if defined(DUP_MASK)
  if ((DUP_MASK >> 0) & 1) hipLaunchKernelGGL(phase_kernel<0>, dim3(grid_blocks), dim3(NTHR), 0, stream, p);
#endif
  hipLaunchKernelGGL(phase_kernel<1>, dim3(grid_blocks), dim3(NTHR), 0, stream, p);
#if defined(DUP_MASK)
  if ((DUP_MASK >> 1) & 1) hipLaunchKernelGGL(phase_kernel<1>, dim3(grid_blocks), dim3(NTHR), 0, stream, p);
#endif
  hipLaunchKernelGGL(phase_kernel<2>, dim3(grid_blocks), dim3(NTHR), 0, stream, p);
#if defined(DUP_MASK)
  if ((DUP_MASK >> 2) & 1) hipLaunchKernelGGL(phase_kernel<2>, dim3(grid_blocks), dim3(NTHR), 0, stream, p);
#endif
  hipLaunchKernelGGL(phase_kernel<3>, dim3(grid_blocks), dim3(NTHR), 0, stream, p);
#if defined(DUP_MASK)
  if ((DUP_MASK >> 3) & 1) hipLaunchKernelGGL(phase_kernel<3>, dim3(grid_blocks), dim3(NTHR), 0, stream, p);
#endif
  hipLaunchKernelGGL(phase_kernel<4>, dim3(grid_blocks), dim3(NTHR), 0, stream, p);
#if defined(DUP_MASK)
  if ((DUP_MASK >> 4) & 1) hipLaunchKernelGGL(phase_kernel<4>, dim3(grid_blocks), dim3(NTHR), 0, stream, p);
#endif
  hipLaunchKernelGGL(phase_kernel<5>, dim3(grid_blocks), dim3(NTHR), 0, stream, p);
#if defined(DUP_MASK)
  if ((DUP_MASK >> 5) & 1) hipLaunchKernelGGL(phase_kernel<5>, dim3(grid_blocks), dim3(NTHR), 0, stream, p);
#endif
  hipLaunchKernelGGL(phase_kernel<6>, dim3(grid_blocks), dim3(NTHR), 0, stream, p);
#if defined(DUP_MASK)
  if ((DUP_MASK >> 6) & 1) hipLaunchKernelGGL(phase_kernel<6>, dim3(grid_blocks), dim3(NTHR), 0, stream, p);
#endif
  hipLaunchKernelGGL(phase_kernel<7>, dim3(grid_blocks), dim3(NTHR), 0, stream, p);
#if defined(DUP_MASK)
  if ((DUP_MASK >> 7) & 1) hipLaunchKernelGGL(phase_kernel<7>, dim3(grid_blocks), dim3(NTHR), 0, stream, p);
#endif
  hipLaunchKernelGGL(phase_kernel<8>, dim3(grid_blocks), dim3(NTHR), 0, stream, p);
#if defined(DUP_MASK)
  if ((DUP_MASK >> 8) & 1) hipLaunchKernelGGL(phase_kernel<8>, dim3(grid_blocks), dim3(NTHR), 0, stream, p);
#endif
#endif
}
```

```cpp
#include <hip/hip_runtime.h>
#include <hip/hip_cooperative_groups.h>
#include <cstdint>
#include <cstdio>
namespace cg = cooperative_groups;

#define DI __device__ __forceinline__
typedef unsigned short bf16_t;
typedef short bf16x8 __attribute__((ext_vector_type(8)));
typedef float f32x16 __attribute__((ext_vector_type(16)));
typedef float f32x4v __attribute__((ext_vector_type(4)));
typedef unsigned u32x4 __attribute__((ext_vector_type(4)));
typedef unsigned u32x2 __attribute__((ext_vector_type(2)));

constexpr int MT = 65536;
constexpr int DM = 1024;
constexpr int TCH = 32;
constexpr int NCH = MT / TCH;
constexpr size_t MiB = (size_t)1 << 20;

constexpr int LDX = 1088;
constexpr int LD5 = 576;
constexpr int LDQ = 320;
constexpr int LDKV = 192;
constexpr int LDWO = 832;
constexpr int LDV = MT + 128;
constexpr size_t OFF_X0 = 0;
constexpr size_t OFF_S = 0;
constexpr size_t OFF_HST = 64 * MiB;
constexpr size_t OFF_U = 136 * MiB;
constexpr size_t OFF_SZS = 208 * MiB;
constexpr size_t OFF_SZA = 272 * MiB;
constexpr size_t OFF_SGS = 336 * MiB;
constexpr size_t OFF_SGA = 464 * MiB;
constexpr size_t OFF_CQ = 592 * MiB;
constexpr size_t OFF_CKV = 632 * MiB;
constexpr size_t OFF_KR = 656 * MiB;
constexpr size_t OFF_YA = 660 * MiB;
constexpr size_t OFF_VT = 732 * MiB;
constexpr size_t OFF_W1T = 797 * MiB;
constexpr size_t OFF_WUQ = 806 * MiB;
constexpr size_t OFF_WUKV = OFF_WUQ + MiB / 2;
constexpr size_t OFF_WGLU = OFF_WUKV + MiB / 2;
constexpr size_t OFF_WBS = OFF_WGLU + MiB;
constexpr size_t OFF_WBA = OFF_WBS + 3 * MiB / 2;
constexpr size_t OFF_WO = OFF_WBA + 3 * MiB / 2;
constexpr size_t OFF_WST = OFF_WO + 5 * MiB / 2;
constexpr size_t OFF_WOUT = OFF_WST + 9 * MiB;
constexpr size_t OFF_LP = OFF_WOUT + 26 * MiB;
constexpr size_t OFF_BT = OFF_LP + 2 * MiB;
constexpr size_t OFF_KT = OFF_BT + MiB;
constexpr size_t OFF_ROPE = OFF_KT + 2 * MiB;
constexpr size_t OFF_STATS = OFF_ROPE + 2 * MiB;
constexpr size_t OFF_BAR = OFF_STATS + 768 * 1024;
constexpr size_t WS_NEEDED = OFF_STATS + MiB;
constexpr size_t OFF_Q = 0;
constexpr size_t OFF_K = 96 * MiB;

constexpr float ALPHA_RES = 1.18920711500272f;
constexpr float QSCALE = 0.14724444f;

struct Params {
  const float *x_prompt, *x_sample, *ln_in_g, *ln_in_b, *w_in, *b_re, *b_im, *a_re_f, *a_im_f, *ldt_f, *c_re_f, *c_im_f, *a_re_b, *a_im_b,
      *ldt_b, *c_re_b, *c_im_b, *ssm_d, *w_glu, *b_glu, *q_norm_g, *w_uq, *kv_norm_g, *w_ukv, *w_bs, *w_ba, *w_o, *ln_g, *ln_b;
  float* out;
  char* ws;
  int pad0, pad1;
};

DI int tidx() { int t = threadIdx.x; asm volatile("" : "+v"(t)); return t; }
DI bf16_t f2bf(float x) { unsigned u = __float_as_uint(x); u += 0x7fffu + ((u >> 16) & 1u); return (bf16_t)(u >> 16); }
DI unsigned pk2(float lo, float hi) { unsigned r; asm("v_cvt_pk_bf16_f32 %0, %1, %2" : "=v"(r) : "v"(lo), "v"(hi)); return r; }
DI float bf2f(bf16_t b) { return __uint_as_float(((unsigned)b) << 16); }
DI float sigmoidf_(float x) { return __builtin_amdgcn_rcpf(1.f + __expf(-x)); }
DI float siluf_(float x) { return x * sigmoidf_(x); }
DI float geluf_(float x) { return x * sigmoidf_(1.5957691216057308f * (x + 0.044715f * x * x * x)); }
DI int crow(int i, int h) { return (i & 3) + 8 * (i >> 2) + 4 * h; }
DI int tok_pos(int t) { return t < 32768 ? (t & 16383) : (t & 8191); }

DI void sincos2pi(double rev, double& s, double& c) {
  rev -= rint(rev);
  double q = rint(rev * 4.0);
  double y = (rev - q * 0.25) * 6.283185307179586476925;
  double y2 = y * y;
  double sp = y * (1.0 + y2 * (-1.0 / 6 + y2 * (1.0 / 120 + y2 * (-1.0 / 5040 + y2 * (1.0 / 362880 + y2 * (-1.0 / 39916800 + y2 * (1.0 / 6227020800.0)))))));
  double cp = 1.0 + y2 * (-0.5 + y2 * (1.0 / 24 + y2 * (-1.0 / 720 + y2 * (1.0 / 40320 + y2 * (-1.0 / 3628800 + y2 * (1.0 / 479001600.0 + y2 * (-1.0 / 87178291200.0)))))));
  int qi = ((int)q) & 3;
  if (qi == 0) { s = sp; c = cp; } else if (qi == 1) { s = cp; c = -sp; } else if (qi == 2) { s = -sp; c = -cp; } else { s = -cp; c = sp; }
}

struct ARow { const bf16_t* p; int ld; DI const bf16_t* operator()(int row, int kc) const { return p + (size_t)row * ld + kc * 8; } };
struct ATwo { const bf16_t* p1; int ld1; int kc1; const bf16_t* p2; int ld2;
  DI const bf16_t* operator()(int row, int kc) const { return kc < kc1 ? p1 + (size_t)row * ld1 + kc * 8 : p2 + (size_t)row * ld2 + (kc - kc1) * 8; } };
struct AGrp { const bf16_t* p; DI const bf16_t* operator()(int row, int kc) const { return p + ((size_t)(kc >> 1) * MT + row) * 16 + (kc & 1) * 8; } };

constexpr int NTHR = 512;
constexpr int STL = 260;
constexpr int OFF_RSS = 256 * 264 * 2;
constexpr int OFF_XBW = OFF_RSS + 1024;
constexpr int SMEM_BYTES = OFF_XBW + 16;
DI int swz(int row, int c) { return row * 128 + ((c ^ ((row >> 1) & 7)) << 4); }

template <class AL, bool ROWSS>
DI void gemm_main(f32x4v (&acc)[8][4], const AL& al, int m0, const bf16_t* __restrict__ Bt, int ldb, int n0, int K, char* smem) {
  const int tid = tidx(), lane = tid & 63, wave = tid >> 6, wm = wave >> 2, wn = wave & 3, fr = lane & 15, fq = lane >> 4;
  const int nk = K >> 6;
#pragma unroll
  for (int m = 0; m < 8; ++m)
#pragma unroll
    for (int n = 0; n < 4; ++n) acc[m][n] = (f32x4v){0.f, 0.f, 0.f, 0.f};
  const int prow = wave * 8 + (lane >> 3);
  const int pch = (lane & 7) ^ ((prow >> 1) & 7);
  const bf16_t* bp = Bt + (size_t)(n0 + prow) * ldb + pch * 8;
#define GLDS_A(BUF, KT)                                                                                                      \
  _Pragma("unroll") for (int i = 0; i < 4; ++i)                                                                               \
    __builtin_amdgcn_global_load_lds((const unsigned*)al(m0 + prow + 64 * i, (KT) * 8 + pch),                                \
                                     (unsigned __attribute__((address_space(3)))*)(smem + (BUF) * 65536 + (i * 64 + wave * 8) * 128), 16, 0, 0);
#define GLDS_B(BUF, KT)                                                                                                      \
  _Pragma("unroll") for (int i = 0; i < 4; ++i)                                                                               \
    __builtin_amdgcn_global_load_lds((const unsigned*)(bp + (size_t)64 * i * ldb + (KT) * 64),                               \
                                     (unsigned __attribute__((address_space(3)))*)(smem + (BUF) * 65536 + 32768 + (i * 64 + wave * 8) * 128), 16, 0, 0);
#define GLDS_STAGE(BUF, KT) GLDS_A(BUF, KT) GLDS_B(BUF, KT)
  GLDS_STAGE(0, 0)
  asm volatile("s_waitcnt vmcnt(0)" ::: "memory");
  __syncthreads();
  for (int kt = 0; kt < nk; ++kt) {
    const char* sa = smem + (kt & 1) * 65536;
    const char* sb = sa + 32768;
    if (kt + 1 < nk) { GLDS_A((kt + 1) & 1, kt + 1) }
#pragma unroll
    for (int kk = 0; kk < 2; ++kk) {
      if (kk == 1 && kt + 1 < nk) { GLDS_B((kt + 1) & 1, kt + 1) }
      bf16x8 af[8], bfr[4];
#pragma unroll
      for (int m = 0; m < 8; ++m) af[m] = *(const bf16x8*)(sa + swz(wm * 128 + m * 16 + fr, kk * 4 + fq));
#pragma unroll
      for (int n = 0; n < 4; ++n) bfr[n] = *(const bf16x8*)(sb + swz(wn * 64 + n * 16 + fr, kk * 4 + fq));
      __builtin_amdgcn_s_setprio(1);
#pragma unroll
      for (int m = 0; m < 8; ++m)
#pragma unroll
        for (int n = 0; n < 4; ++n) acc[m][n] = __builtin_amdgcn_mfma_f32_16x16x32_bf16(af[m], bfr[n], acc[m][n], 0, 0, 0);
      __builtin_amdgcn_s_setprio(0);
    }
    asm volatile("s_waitcnt vmcnt(0)" ::: "memory");
    __syncthreads();
  }
#undef GLDS_STAGE
#undef GLDS_A
#undef GLDS_B
}

template <int SL> DI void stage_slab(const f32x4v (&acc)[8][4], float* st) {
  const int lane = tidx() & 63, wave = tidx() >> 6, wm = wave >> 2, wn = wave & 3, fr = lane & 15, fq = lane >> 4;
  if (wm == SL) {
#pragma unroll
    for (int m = 0; m < 8; ++m)
#pragma unroll
      for (int n = 0; n < 4; ++n)
#pragma unroll
        for (int j = 0; j < 4; ++j) st[(m * 16 + fq * 4 + j) * STL + wn * 64 + n * 16 + fr] = acc[m][n][j];
  }
  __syncthreads();
}
DI void ld8(const float* st, float (&v)[8]) { const float4 a = *(const float4*)st, b = *(const float4*)(st + 4); v[0] = a.x; v[1] = a.y; v[2] = a.z; v[3] = a.w; v[4] = b.x; v[5] = b.y; v[6] = b.z; v[7] = b.w; }
DI void ld8bf(const bf16_t* p, float (&v)[8]) {
  const u32x4 w = *(const u32x4*)p;
#pragma unroll
  for (int j = 0; j < 4; ++j) { v[2 * j] = __uint_as_float(w[j] << 16); v[2 * j + 1] = __uint_as_float(w[j] & 0xffff0000u); }
}
DI void st8bf(bf16_t* p, const float (&v)[8]) { u32x4 w; w.x = pk2(v[0], v[1]); w.y = pk2(v[2], v[3]); w.z = pk2(v[4], v[5]); w.w = pk2(v[6], v[7]); *(u32x4*)p = w; }
#define EPI_SLAB(SL, ...)                                                     \
  { stage_slab<SL>(acc, st);                                                   \
    _Pragma("unroll 1") for (int it_ = 0; it_ < 8; ++it_) {                     \
      const int gid_ = it_ * NTHR + tidx(); const int srow_ = gid_ >> 5, lrow = (SL) * 128 + srow_, lc0 = (gid_ & 31) * 8; (void)lrow; \
      float v[8]; ld8(st + srow_ * STL + lc0, v);                              \
      __VA_ARGS__ }                                                            \
    __syncthreads(); }
#define EPI_ALL(...) EPI_SLAB(0, __VA_ARGS__) EPI_SLAB(1, __VA_ARGS__)

DI void ph_tables(const Params& P) {
  const int gt = blockIdx.x * blockDim.x + tidx(), gs = gridDim.x * blockDim.x;
  float2* LP = (float2*)(P.ws + OFF_LP);
  float2* BT = (float2*)(P.ws + OFF_BT);
  float2* ROPE = (float2*)(P.ws + OFF_ROPE);
  for (int idx = gt; idx < 32 * 2 * 64; idx += gs) {
    const int n = idx & 63, dir = (idx >> 6) & 1, g = idx >> 7;
    const double are = dir ? (double)P.a_re_b[g * 64 + n] : (double)P.a_re_f[g * 64 + n];
    const double aim = dir ? (double)P.a_im_b[g * 64 + n] : (double)P.a_im_f[g * 64 + n];
    const double dt = exp(dir ? (double)P.ldt_b[g] : (double)P.ldt_f[g]);
    double l1r = 1.0, l1i = 0.0;
    for (int d = 0; d <= 32; ++d) {
      const double mag = exp(are * dt * d);
      double s, c; sincos2pi(aim * dt * d * 0.15915494309189533577, s, c);
      LP[((g * 2 + dir) * 33 + d) * 64 + n] = make_float2((float)(mag * c), (float)(mag * s));
      if (d == 1) { l1r = mag * c; l1i = mag * s; }
    }
    const double zr = are * dt, zi = aim * dt;
    double cr, ci;
    if (zr * zr + zi * zi < 0.25) {
      double tr = 1.0, ti = 0.0, sr = 1.0, si = 0.0;
      for (int k = 1; k < 24; ++k) { const double nr = (tr * zr - ti * zi) / (k + 1), ni = (tr * zi + ti * zr) / (k + 1); tr = nr; ti = ni; sr += tr; si += ti; }
      cr = sr * dt; ci = si * dt;
    } else {
      const double nr = l1r - 1.0, ni = l1i, den = are * are + aim * aim;
      cr = (nr * are + ni * aim) / den; ci = (ni * are - nr * aim) / den;
    }
    for (int q = 0; q < 16; ++q) {
      const double br = P.b_re[(g * 64 + n) * 16 + q], bi = P.b_im[(g * 64 + n) * 16 + q];
      BT[((g * 2 + dir) * 64 + n) * 16 + q] = make_float2((float)(br * cr - bi * ci), (float)(br * ci + bi * cr));
    }
  }
  for (int idx = gt; idx < 16384 * 16; idx += gs) {
    const int j = idx & 15, pos = idx >> 4;
    const double inv = exp(-(double)j * (9.210340371976182736 / 16.0));
    double s, c; sincos2pi((double)pos * inv * 0.15915494309189533577, s, c);
    ROPE[idx] = make_float2((float)c, (float)s);
  }
}

DI void transpose_tile(const float* __restrict__ src, int lds_, int ldd, bf16_t* __restrict__ dst, int k0, int n0, int mode, const float* __restrict__ rowscale, float* tile) {
  const int tid = tidx();
  {
    const int nn = tid & 63, n = n0 + nn;
    int sc = n;
    if (mode == 1) sc = n < 1440 ? n : (n < 1536 ? -1 : n - 96);
#pragma unroll 4
    for (int i = 0; i < 8; ++i) {
      const int kk = (tid >> 6) + 8 * i, k = k0 + kk;
      float v = sc >= 0 ? src[(size_t)k * lds_ + sc] : 0.f;
      if (rowscale) v *= rowscale[k];
      tile[kk * 65 + nn] = v;
    }
  }
  __syncthreads();
  {
    const int kk = tid & 63;
#pragma unroll 4
    for (int i = 0; i < 8; ++i) { const int nn = (tid >> 6) + 8 * i; dst[(size_t)(n0 + nn) * ldd + k0 + kk] = f2bf(tile[kk * 65 + nn]); }
  }
  __syncthreads();
}

DI void ph_prep(const Params& P, char* smem) {
  const int gt = blockIdx.x * blockDim.x + tidx(), gs = gridDim.x * blockDim.x;
  const float2* LP = (const float2*)(P.ws + OFF_LP);
  const float2* BT = (const float2*)(P.ws + OFF_BT);
  float* KT = (float*)(P.ws + OFF_KT);
  bf16_t* WST = (bf16_t*)(P.ws + OFF_WST);
  bf16_t* WOUT = (bf16_t*)(P.ws + OFF_WOUT);
  for (int idx = gt; idx < 32 * 2 * 32 * 256; idx += gs) {
    const int q = idx & 15, p = (idx >> 4) & 15, d = (idx >> 8) & 31, dir = (idx >> 13) & 1, g = idx >> 14;
    const float* cre = (dir ? P.c_re_b : P.c_re_f) + (g * 16 + p) * 64;
    const float* cim = (dir ? P.c_im_b : P.c_im_f) + (g * 16 + p) * 64;
    const float2* lp = LP + ((g * 2 + dir) * 33 + d) * 64;
    const float2* bt = BT + ((g * 2 + dir) * 64) * 16 + q;
    float s = 0.f;
    for (int n = 0; n < 64; ++n) {
      const float2 l = lp[n], b = bt[n * 16];
      const float wr = l.x * b.x - l.y * b.y, wi = l.x * b.y + l.y * b.x;
      s += cre[n] * wr - cim[n] * wi;
    }
    KT[idx] = s;
  }
  for (int idx = gt; idx < 32 * 256 * 512; idx += gs) {
    const int k = idx & 511, np = (idx >> 9) & 255, g = idx >> 17;
    const int q = k & 15, s = k >> 4, n = np & 63, reim = (np >> 6) & 1, dir = np >> 7;
    const int e = dir ? s : (TCH - 1 - s);
    const float2 l = LP[((g * 2 + dir) * 33 + e) * 64 + n], b = BT[((g * 2 + dir) * 64 + n) * 16 + q];
    const float val = reim ? (l.x * b.y + l.y * b.x) : (l.x * b.x - l.y * b.y);
    WST[((size_t)g * 256 + np) * LD5 + k] = f2bf(val);
  }
  for (int idx = gt; idx < 32 * 512 * 256; idx += gs) {
    const int k2 = idx & 255, tp = (idx >> 8) & 511, g = idx >> 17;
    const int n = k2 & 63, reim = (k2 >> 6) & 1, dir = k2 >> 7, p = tp & 15, t = tp >> 4;
    const int e = dir ? (TCH - t) : (t + 1);
    const float2 l = LP[((g * 2 + dir) * 33 + e) * 64 + n];
    const float cr = (dir ? P.c_re_b : P.c_re_f)[(g * 16 + p) * 64 + n], ci = (dir ? P.c_im_b : P.c_im_f)[(g * 16 + p) * 64 + n];
    const float val = reim ? -(cr * l.y + ci * l.x) : (cr * l.x - ci * l.y);
#ifdef PROBE_NO_CONV
    WOUT[((size_t)g * 512 + tp) * LDWO + 512 + k2] = 0;
#else
    WOUT[((size_t)g * 512 + tp) * LDWO + 512 + k2] = f2bf(val);
#endif
  }
  {
    float* tile = (float*)smem;
    for (int u = blockIdx.x; u < 1680; u += gridDim.x) {
      if (u < 1024) transpose_tile(P.w_in, 4000, LDX, (bf16_t*)(P.ws + OFF_W1T), (u & 15) * 64, (u >> 4) * 64, 1, nullptr, tile);
      else if (u < 1072) { const int v = u - 1024; transpose_tile(P.w_uq, 768, LDQ, (bf16_t*)(P.ws + OFF_WUQ), (v & 3) * 64, (v >> 2) * 64, 0, P.q_norm_g, tile); }
      else if (u < 1104) { const int v = u - 1072; transpose_tile(P.w_ukv, 1024, LDKV, (bf16_t*)(P.ws + OFF_WUKV), (v & 1) * 64, (v >> 1) * 64, 0, P.kv_norm_g, tile); }
      else if (u < 1168) { const int v = u - 1104; transpose_tile(P.w_glu, 512, LD5, (bf16_t*)(P.ws + OFF_WGLU), (v & 7) * 64, (v >> 3) * 64, 0, nullptr, tile); }
      else if (u < 1296) { const int v = u - 1168; transpose_tile(P.w_bs, 1024, LD5, (bf16_t*)(P.ws + OFF_WBS), (v & 7) * 64, (v >> 3) * 64, 0, nullptr, tile); }
      else if (u < 1424) { const int v = u - 1296; transpose_tile(P.w_ba, 1024, LD5, (bf16_t*)(P.ws + OFF_WBA), (v & 7) * 64, (v >> 3) * 64, 0, nullptr, tile); }
      else { const int v = u - 1424; transpose_tile(P.w_o, 1024, LDX, (bf16_t*)(P.ws + OFF_WO), (v & 15) * 64, (v >> 4) * 64, 0, nullptr, tile); }
    }
  }
  {
    bf16_t* X0 = (bf16_t*)(P.ws + OFF_X0);
    float2* STATS = (float2*)(P.ws + OFF_STATS);
    const int lane = tidx() & 63, gw = gt >> 6, nw = gs >> 6;
    for (int row0 = gw * 4; row0 < MT; row0 += nw * 4) {
      float4 v[4][4];
#pragma unroll
      for (int rr = 0; rr < 4; ++rr) {
        const int row = row0 + rr;
        const float* xr = row < 32768 ? P.x_prompt + (size_t)row * DM : P.x_sample + (size_t)(row - 32768) * DM;
#pragma unroll
        for (int i = 0; i < 4; ++i) v[rr][i] = *(const float4*)(xr + i * 256 + lane * 4);
      }
#pragma unroll
      for (int rr = 0; rr < 4; ++rr) {
        const int row = row0 + rr;
        float s = 0.f;
#pragma unroll
        for (int i = 0; i < 4; ++i) s += (v[rr][i].x + v[rr][i].y) + (v[rr][i].z + v[rr][i].w);
#pragma unroll
        for (int o = 32; o >= 1; o >>= 1) s += __shfl_xor(s, o);
        const float mu = s * (1.f / 1024.f);
        float q = 0.f;
#pragma unroll
        for (int i = 0; i < 4; ++i) { const float a = v[rr][i].x - mu, b = v[rr][i].y - mu, c = v[rr][i].z - mu, d = v[rr][i].w - mu; q += (a * a + b * b) + (c * c + d * d); }
#pragma unroll
        for (int o = 32; o >= 1; o >>= 1) q += __shfl_xor(q, o);
        const float rstd = rsqrtf(q * (1.f / 1024.f) + 1e-5f);
        if (lane == 0) STATS[row] = make_float2(mu, rstd);
#pragma unroll
        for (int i = 0; i < 4; ++i) {
          const int c = i * 256 + lane * 4;
          const float4 g = *(const float4*)(P.ln_in_g + c), b = *(const float4*)(P.ln_in_b + c);
          u32x2 o;
          o.x = pk2((v[rr][i].x - mu) * rstd * g.x + b.x, (v[rr][i].y - mu) * rstd * g.y + b.y);
          o.y = pk2((v[rr][i].z - mu) * rstd * g.z + b.z, (v[rr][i].w - mu) * rstd * g.w + b.w);
          *(u32x2*)(X0 + (size_t)row * LDX + c) = o;
        }
      }
    }
  }
}

DI void ph_g1(const Params& P, char* smem) {
  const int gt = blockIdx.x * blockDim.x + tidx(), gs = gridDim.x * blockDim.x;
  {
    const float* KT = (const float*)(P.ws + OFF_KT);
    bf16_t* WOUT = (bf16_t*)(P.ws + OFF_WOUT);
    for (int idx = gt; idx < 32 * 512 * 512; idx += gs) {
      const int k = idx & 511, tp = (idx >> 9) & 511, g = idx >> 18;
      const int q = k & 15, s = k >> 4, p = tp & 15, t = tp >> 4;
      float val;
      if (s < t) val = KT[(((g * 2 + 0) * 32 + (t - s)) * 16 + p) * 16 + q];
      else if (s > t) val = KT[(((g * 2 + 1) * 32 + (s - t)) * 16 + p) * 16 + q];
      else val = KT[(((g * 2 + 0) * 32) * 16 + p) * 16 + q] + KT[(((g * 2 + 1) * 32) * 16 + p) * 16 + q] + (p == q ? P.ssm_d[g * 16 + p] : 0.f);
#ifdef PROBE_NO_CONV
      val = (s == t && p == q) ? P.ssm_d[g * 16 + p] : 0.f;
#endif
      WOUT[((size_t)g * 512 + tp) * LDWO + k] = f2bf(val);
    }
  }
  const bf16_t* X0 = (const bf16_t*)(P.ws + OFF_X0);
  const bf16_t* W1T = (const bf16_t*)(P.ws + OFF_W1T);
  bf16_t* U = (bf16_t*)(P.ws + OFF_U);
  bf16_t* SZS = (bf16_t*)(P.ws + OFF_SZS);
  bf16_t* SZA = (bf16_t*)(P.ws + OFF_SZA);
  bf16_t* SGS = (bf16_t*)(P.ws + OFF_SGS);
  bf16_t* SGA = (bf16_t*)(P.ws + OFF_SGA);
  bf16_t* CQ = (bf16_t*)(P.ws + OFF_CQ);
  bf16_t* CKV = (bf16_t*)(P.ws + OFF_CKV);
  bf16_t* KR = (bf16_t*)(P.ws + OFF_KR);
  const float2* ROPE = (const float2*)(P.ws + OFF_ROPE);
  float* st = (float*)smem;
  for (int tile = blockIdx.x; tile < 256 * 16; tile += gridDim.x) {
    const int rnd = tile >> 8, bb = tile & 255, xcd = bb & 7, slot = bb >> 3;
    const int mt = (rnd & 7) * 32 + xcd * 4 + (slot & 3), nt = (rnd >> 3) * 8 + (slot >> 2), m0 = mt * 256, n0 = nt * 256;
    f32x4v acc[8][4];
    gemm_main<ARow, false>(acc, ARow{X0, LDX}, m0, W1T, LDX, n0, 1024, smem);
    if (nt < 2) {
      EPI_ALL({ const int col = n0 + lc0, tok = m0 + lrow; st8bf(U + ((size_t)(col >> 4) * NCH + (tok >> 5)) * LD5 + (tok & 31) * 16 + (col & 15), v); })
    } else if (nt < 4) {
      EPI_ALL({
        _Pragma("unroll") for (int j = 0; j < 8; ++j) v[j] = siluf_(v[j]);
        st8bf(SZS + (size_t)(m0 + lrow) * 512 + n0 - 512 + lc0, v); })
    } else if (nt == 4) {
      EPI_ALL({ st8bf(CQ + (size_t)(m0 + lrow) * LDQ + lc0, v); })
    } else if (nt == 5) {
      EPI_ALL({
        const int tok = m0 + lrow;
        if (lc0 < 128) st8bf(CKV + (size_t)tok * LDKV + lc0, v);
        else if (lc0 < 160) {
          const int c = lc0 - 128; const float2* cs = ROPE + tok_pos(tok) * 16 + (c & 15);
          float pv[8]; ld8(st + srow_ * STL + (lc0 ^ 16), pv);
          float o[8];
          _Pragma("unroll") for (int j = 0; j < 8; ++j) o[j] = c < 16 ? v[j] * cs[j].x - pv[j] * cs[j].y : pv[j] * cs[j].y + v[j] * cs[j].x;
          st8bf(KR + (size_t)tok * 32 + c, o);
        } })
    } else if (nt < 8) {
      EPI_ALL({
        _Pragma("unroll") for (int j = 0; j < 8; ++j) v[j] = siluf_(v[j]);
        st8bf(SZA + (size_t)(m0 + lrow) * 512 + n0 - 1536 + lc0, v); })
    } else if (nt < 12) {
      EPI_ALL({
        _Pragma("unroll") for (int j = 0; j < 8; ++j) v[j] = sigmoidf_(v[j]);
        st8bf(SGS + (size_t)(m0 + lrow) * 1024 + n0 - 2048 + lc0, v); })
    } else {
      EPI_ALL({
        _Pragma("unroll") for (int j = 0; j < 8; ++j) v[j] = sigmoidf_(v[j]);
        st8bf(SGA + (size_t)(m0 + lrow) * 1024 + n0 - 3072 + lc0, v); })
    }
  }
}

template <int KD> DI void row_rms_scale(const bf16_t* A, int lda, int m0, float mul, float* rssw) {
  const int row = tidx() >> 1, hf = tidx() & 1;
  const bf16_t* p = A + (size_t)(m0 + row) * lda + hf * (KD / 2);
  float ss = 0.f;
#pragma unroll
  for (int c = 0; c < KD / 16; ++c) {
    const u32x4 w = *(const u32x4*)(p + c * 8);
#pragma unroll
    for (int j = 0; j < 4; ++j) { const float lo = __uint_as_float(w[j] << 16), hi = __uint_as_float(w[j] & 0xffff0000u); ss += lo * lo + hi * hi; }
  }
  ss += __shfl_xor(ss, 1);
  if (hf == 0) rssw[row] = rsqrtf(ss * (1.f / KD) + 1e-6f) * mul;
}

constexpr int SH = 264;
DI void stage_tile_bf16(const f32x4v (&acc)[8][4], bf16_t* sth) {
  const int lane = tidx() & 63, wave = tidx() >> 6, wm = wave >> 2, wn = wave & 3, fr = lane & 15, fq = lane >> 4;
#pragma unroll
  for (int m = 0; m < 8; ++m)
#pragma unroll
    for (int n = 0; n < 4; ++n)
#pragma unroll
      for (int j = 0; j < 4; ++j) sth[(wm * 128 + m * 16 + fq * 4 + j) * SH + wn * 64 + n * 16 + fr] = f2bf(acc[m][n][j]);
  __syncthreads();
}

DI void ph_qkv(const Params& P, char* smem) {
  const bf16_t* CQ = (const bf16_t*)(P.ws + OFF_CQ);
  const bf16_t* CKV = (const bf16_t*)(P.ws + OFF_CKV);
  const bf16_t* KR = (const bf16_t*)(P.ws + OFF_KR);
  const bf16_t* U = (const bf16_t*)(P.ws + OFF_U);
  const float2* ROPE = (const float2*)(P.ws + OFF_ROPE);
  bf16_t* Q = (bf16_t*)((char*)P.out + OFF_Q);
  bf16_t* KM = (bf16_t*)((char*)P.out + OFF_K);
  bf16_t* VT = (bf16_t*)(P.ws + OFF_VT);
  float* S = (float*)(P.ws + OFF_S);
  float* rss = (float*)(smem + OFF_RSS);
  float* st = (float*)smem;
  bf16_t* sth = (bf16_t*)smem;
  for (int u = blockIdx.x; u < 768; u += gridDim.x) {
    const int nt = u % 3, mt = u / 3, m0 = mt * 256, n0 = nt * 256;
    f32x4v acc[8][4];
    row_rms_scale<256>(CQ, LDQ, m0, QSCALE, rss);
    gemm_main<ARow, false>(acc, ARow{CQ, LDQ}, m0, (const bf16_t*)(P.ws + OFF_WUQ), LDQ, n0, 256, smem);
    stage_tile_bf16(acc, sth);
#pragma unroll 1
    for (int it = 0; it < 16; ++it) {
      const int gid = it * NTHR + tidx(), lrow = gid >> 5, lc0 = (gid & 31) * 8;
      const int col = n0 + lc0, head = col / 96, c = col - head * 96, tok = m0 + lrow;
      const float sc = rss[lrow];
      float v[8], o[8];
      ld8bf(sth + lrow * SH + lc0, v);
      if (c >= 64) {
        const float2* cs = ROPE + tok_pos(tok) * 16 + (c & 15);
        float pv[8]; ld8bf(sth + lrow * SH + (lc0 ^ 16), pv);
#pragma unroll
        for (int j = 0; j < 8; ++j) o[j] = ((c & 16) ? pv[j] * cs[j].y + v[j] * cs[j].x : v[j] * cs[j].x - pv[j] * cs[j].y) * sc;
      } else {
#pragma unroll
        for (int j = 0; j < 8; ++j) o[j] = v[j] * sc;
      }
      st8bf(Q + ((size_t)head * MT + tok) * 96 + c, o);
    }
    __syncthreads();
  }
  for (int u = blockIdx.x; u < 1024; u += gridDim.x) {
    const int hp = u & 3, mt = u >> 2, m0 = mt * 256, n0 = hp * 256;
    f32x4v acc[8][4];
    row_rms_scale<128>(CKV, LDKV, m0, 1.f, rss);
    gemm_main<ARow, false>(acc, ARow{CKV, LDKV}, m0, (const bf16_t*)(P.ws + OFF_WUKV), LDKV, n0, 128, smem);
    stage_tile_bf16(acc, sth);
#pragma unroll 1
    for (int it = 0; it < 8; ++it) {
      const int gid = it * NTHR + tidx(), lrow = gid >> 4, cg = gid & 15, hl = cg >> 3, c0 = (cg & 7) * 8, tok = m0 + lrow;
      const float sc = rss[lrow];
      float v[8]; ld8bf(sth + lrow * SH + hl * 128 + c0, v);
#pragma unroll
      for (int j = 0; j < 8; ++j) v[j] *= sc;
      st8bf(KM + ((size_t)(hp * 2 + hl) * MT + tok) * 96 + c0, v);
    }
#pragma unroll 1
    for (int it = 0; it < 8; ++it) {
      const int gid = it * NTHR + tidx(), cv = gid >> 5, rg = (gid & 31) * 8, hl = cv >> 6, dv = cv & 63;
      float v[8];
#pragma unroll
      for (int j = 0; j < 8; ++j) v[j] = bf2f(sth[(rg + j) * SH + hl * 128 + 64 + dv]) * rss[rg + j];
      st8bf(VT + ((size_t)(hp * 2 + hl) * 64 + dv) * LDV + m0 + rg, v);
    }
    {
      const int tok = m0 + (tidx() >> 1), hf = tidx() & 1;
      const u32x4* sp = (const u32x4*)(KR + (size_t)tok * 32 + hf * 16);
      const u32x4 a = sp[0], b = sp[1];
#pragma unroll
      for (int hl = 0; hl < 2; ++hl) {
        u32x4* d = (u32x4*)(KM + ((size_t)(hp * 2 + hl) * MT + tok) * 96 + 64 + hf * 16);
        d[0] = a; d[1] = b;
      }
    }
    __syncthreads();
  }
  for (int u = blockIdx.x; u < 256; u += gridDim.x) {
    const int mt = u & 7, g = u >> 3, m0 = mt * 256;
    f32x4v acc[8][4];
    gemm_main<ARow, false>(acc, ARow{U + (size_t)g * NCH * LD5, LD5}, m0, (const bf16_t*)(P.ws + OFF_WST) + (size_t)g * 256 * LD5, LD5, 0, 512, smem);
    EPI_ALL({
      float* d = S + ((size_t)g * NCH + m0 + lrow) * 256 + lc0;
      *(float4*)d = make_float4(v[0], v[1], v[2], v[3]); *(float4*)(d + 4) = make_float4(v[4], v[5], v[6], v[7]); })
  }
}

DI void ph_scan(const Params& P, char* smem) {
  const float* S = (const float*)(P.ws + OFF_S);
  bf16_t* HST = (bf16_t*)(P.ws + OFF_HST);
  const float2* LP = (const float2*)(P.ws + OFF_LP);
  float2* E = (float2*)smem;
  const int n = tidx() & 63, sg = tidx() >> 6;
  for (int job = blockIdx.x; job < 384; job += gridDim.x) {
    const int dir = job & 1, g = (job >> 1) & 31, seq = job >> 6;
    const int c0 = seq < 2 ? seq * 512 : 1024 + (seq - 2) * 256, nc = seq < 2 ? 512 : 256, segl = nc >> 3;
    const float2 a = LP[((g * 2 + dir) * 33 + 32) * 64 + n];
    const float* Sg = S + (size_t)g * NCH * 256 + dir * 128 + n;
    bf16_t* Hg = HST + (size_t)g * NCH * LDQ + dir * 128 + n;
    const int j0 = sg * segl;
    float hr = 0.f, hi = 0.f;
    for (int jb = 0; jb < segl; jb += 32) {
      float sr[32], si[32];
#pragma unroll
      for (int j = 0; j < 32; ++j) { const int jj = j0 + jb + j, c = dir ? (c0 + nc - 1 - jj) : (c0 + jj); sr[j] = Sg[(size_t)c * 256]; si[j] = Sg[(size_t)c * 256 + 64]; }
#pragma unroll
      for (int j = 0; j < 32; ++j) { const float nr = a.x * hr - a.y * hi + sr[j], ni = a.x * hi + a.y * hr + si[j]; hr = nr; hi = ni; }
    }
    E[sg * 64 + n] = make_float2(hr, hi);
    float pr = a.x, pi = a.y;
    for (int q = segl; q > 1; q >>= 1) { const float nr = pr * pr - pi * pi, ni = 2.f * pr * pi; pr = nr; pi = ni; }
    __syncthreads();
    hr = 0.f; hi = 0.f;
    for (int t = 0; t < sg; ++t) { const float2 e = E[t * 64 + n]; const float nr = pr * hr - pi * hi + e.x, ni = pr * hi + pi * hr + e.y; hr = nr; hi = ni; }
    for (int jb = 0; jb < segl; jb += 32) {
      float sr[32], si[32];
#pragma unroll
      for (int j = 0; j < 32; ++j) { const int jj = j0 + jb + j, c = dir ? (c0 + nc - 1 - jj) : (c0 + jj); sr[j] = Sg[(size_t)c * 256]; si[j] = Sg[(size_t)c * 256 + 64]; }
#pragma unroll
      for (int j = 0; j < 32; ++j) {
        const int jj = j0 + jb + j, c = dir ? (c0 + nc - 1 - jj) : (c0 + jj);
        Hg[(size_t)c * LDQ] = f2bf(hr); Hg[(size_t)c * LDQ + 64] = f2bf(hi);
        const float nr = a.x * hr - a.y * hi + sr[j], ni = a.x * hi + a.y * hr + si[j]; hr = nr; hi = ni;
      }
    }
    __syncthreads();
  }
}

DI void attn_unit(const Params& P, int tok0, int L, int head, int q0, char* smem) {
  const int tid = tidx(), lane = tid & 63, wave = tid >> 6, r = lane & 31, h = lane >> 5;
  const bf16_t* Qh = (const bf16_t*)((char*)P.out + OFF_Q) + (size_t)head * MT * 96;
  const bf16_t* Kh = (const bf16_t*)((char*)P.out + OFF_K) + ((size_t)head * MT + tok0) * 96;
  const bf16_t* Vh = (const bf16_t*)(P.ws + OFF_VT) + (size_t)head * 64 * LDV + tok0;
  const bf16_t* SZA = (const bf16_t*)(P.ws + OFF_SZA);
  bf16_t* YA = (bf16_t*)(P.ws + OFF_YA);
  const int qtok = tok0 + q0 + wave * 32 + r;
  bf16x8 qf[6];
#pragma unroll
  for (int ks = 0; ks < 6; ++ks) qf[ks] = *(const bf16x8*)(Qh + (size_t)qtok * 96 + ks * 16 + h * 8);
  f32x16 O[2];
  f32x16 negm;
#pragma unroll
  for (int i = 0; i < 16; ++i) { O[0][i] = 0.f; O[1][i] = 0.f; negm[i] = 0.f; }
  float l = 0.f;
  constexpr int KSTR = 208, VSTR = 264, KBYTES = 128 * KSTR, STG = KBYTES + 64 * VSTR;
  u32x4 rk[3], rv[2];
  int kgo[3], klo[3];
#pragma unroll
  for (int i = 0; i < 3; ++i) { const int id = tid + 512 * i, kr = id / 12, kc = id - kr * 12; kgo[i] = kr * 96 + kc * 8; klo[i] = kr * KSTR + kc * 16; }
  const int vrow = tid >> 4, vch = tid & 15;
  const int nkt = L >> 7;
#define KV_LOAD(KT)                                                                                               \
  { const int key0_ = (KT) * 128;                                                                                 \
    _Pragma("unroll") for (int i = 0; i < 3; ++i) rk[i] = *(const u32x4*)(Kh + (size_t)key0_ * 96 + kgo[i]);      \
    _Pragma("unroll") for (int i = 0; i < 2; ++i) rv[i] = *(const u32x4*)(Vh + (size_t)(vrow + 32 * i) * LDV + key0_ + vch * 8); }
#define KV_WRITE(BUF)                                                                                             \
  { char* sk_ = smem + (BUF) * STG; char* sv_ = sk_ + KBYTES;                                                     \
    _Pragma("unroll") for (int i = 0; i < 3; ++i) *(u32x4*)(sk_ + klo[i]) = rk[i];                                \
    _Pragma("unroll") for (int i = 0; i < 2; ++i) { char* d = sv_ + (vrow + 32 * i) * VSTR + vch * 16;            \
      *(u32x2*)d = (u32x2){rv[i].x, rv[i].y}; *(u32x2*)(d + 8) = (u32x2){rv[i].z, rv[i].w}; } }
  KV_LOAD(0)
  KV_WRITE(0)
  if (1 < nkt) KV_LOAD(1)
  for (int kt = 0; kt < nkt; ++kt) {
    char* sk0 = smem + (kt & 1) * STG;
    char* sv0 = sk0 + KBYTES;
    __syncthreads();
    if (kt + 1 < nkt) { char* sk_ = smem + ((kt + 1) & 1) * STG;
      _Pragma("unroll") for (int i = 0; i < 3; ++i) *(u32x4*)(sk_ + klo[i]) = rk[i]; }
    if (kt + 2 < nkt) { const int key0_ = (kt + 2) * 128;
      _Pragma("unroll") for (int i = 0; i < 3; ++i) rk[i] = *(const u32x4*)(Kh + (size_t)key0_ * 96 + kgo[i]); }
    f32x16 S[2][2];
#pragma unroll
    for (int hf = 0; hf < 2; ++hf)
#pragma unroll
      for (int kb = 0; kb < 2; ++kb) {
#pragma unroll
        for (int ks = 0; ks < 6; ++ks) {
          const bf16x8 kf = *(const bf16x8*)(sk0 + (hf * 64 + kb * 32 + r) * KSTR + (ks * 2 + h) * 16);
          S[hf][kb] = __builtin_amdgcn_mfma_f32_32x32x16_bf16(kf, qf[ks], ks == 0 ? negm : S[hf][kb], 0, 0, 0);
        }
      }
    __builtin_amdgcn_sched_barrier(0);
    if (kt + 1 < nkt) { char* sv_ = smem + ((kt + 1) & 1) * STG + KBYTES;
      _Pragma("unroll") for (int i = 0; i < 2; ++i) { char* d = sv_ + (vrow + 32 * i) * VSTR + vch * 16;
        *(u32x2*)d = (u32x2){rv[i].x, rv[i].y}; *(u32x2*)(d + 8) = (u32x2){rv[i].z, rv[i].w}; } }
    if (kt + 2 < nkt) { const int key0_ = (kt + 2) * 128;
      _Pragma("unroll") for (int i = 0; i < 2; ++i) rv[i] = *(const u32x4*)(Vh + (size_t)(vrow + 32 * i) * LDV + key0_ + vch * 8); }
    __builtin_amdgcn_sched_barrier(0);
    float mx = fmaxf(fmaxf(S[0][0][0], S[0][0][1]), S[0][0][2]);
#pragma unroll
    for (int i = 3; i < 15; i += 2) mx = fmaxf(fmaxf(mx, S[0][0][i]), S[0][0][i + 1]);
    mx = fmaxf(mx, S[0][0][15]);
#pragma unroll
    for (int i = 0; i < 16; i += 2) mx = fmaxf(fmaxf(mx, S[0][1][i]), S[0][1][i + 1]);
#pragma unroll
    for (int i = 0; i < 16; i += 2) mx = fmaxf(fmaxf(mx, S[1][0][i]), S[1][0][i + 1]);
#pragma unroll
    for (int i = 0; i < 16; i += 2) mx = fmaxf(fmaxf(mx, S[1][1][i]), S[1][1][i + 1]);
    if (kt == 0 || __any(mx > 8.f)) {
      const float mxf = fmaxf(mx, __shfl_xor(mx, 32));
      const float delta = kt == 0 ? mxf : fmaxf(mxf, 0.f);
      const float alpha = kt == 0 ? 1.f : __builtin_amdgcn_exp2f(-delta);
      l *= alpha;
      const float nm = negm[0] - delta;
#pragma unroll
      for (int i = 0; i < 16; ++i) {
        O[0][i] *= alpha; O[1][i] *= alpha; negm[i] = nm;
        S[0][0][i] -= delta; S[0][1][i] -= delta; S[1][0][i] -= delta; S[1][1][i] -= delta;
      }
    }
    float ps = 0.f;
    bf16x8 pf[2][2][2];
#pragma unroll
    for (int hf = 0; hf < 2; ++hf) {
#pragma unroll
      for (int kb = 0; kb < 2; ++kb)
#pragma unroll
        for (int i = 0; i < 16; ++i) { S[hf][kb][i] = __builtin_amdgcn_exp2f(S[hf][kb][i]); ps += S[hf][kb][i]; }
#pragma unroll
      for (int kb = 0; kb < 2; ++kb)
#pragma unroll
        for (int s2 = 0; s2 < 2; ++s2) {
          u32x4 w;
          w.x = pk2(S[hf][kb][8 * s2 + 0], S[hf][kb][8 * s2 + 1]); w.y = pk2(S[hf][kb][8 * s2 + 2], S[hf][kb][8 * s2 + 3]);
          w.z = pk2(S[hf][kb][8 * s2 + 4], S[hf][kb][8 * s2 + 5]); w.w = pk2(S[hf][kb][8 * s2 + 6], S[hf][kb][8 * s2 + 7]);
          pf[hf][kb][s2] = __builtin_bit_cast(bf16x8, w);
        }
    }
    l += ps;
#pragma unroll
    for (int hf = 0; hf < 2; ++hf)
#pragma unroll
      for (int db = 0; db < 2; ++db)
#pragma unroll
        for (int kb = 0; kb < 2; ++kb)
#pragma unroll
          for (int s2 = 0; s2 < 2; ++s2) {
            const char* a = sv0 + hf * 128 + (db * 32 + r) * VSTR + (kb * 32 + s2 * 16 + h * 4) * 2;
            const u32x2 lo = *(const u32x2*)a, hi = *(const u32x2*)(a + 16);
            const u32x4 w = {lo.x, lo.y, hi.x, hi.y};
            O[db] = __builtin_amdgcn_mfma_f32_32x32x16_bf16(__builtin_bit_cast(bf16x8, w), pf[hf][kb][s2], O[db], 0, 0, 0);
          }
  }
#undef KV_LOAD
#undef KV_WRITE
  __syncthreads();
  l += __shfl_xor(l, 32);
  const float inv = 1.f / l;
#pragma unroll
  for (int db = 0; db < 2; ++db)
#pragma unroll
    for (int g4 = 0; g4 < 4; ++g4) {
      const size_t o = (size_t)qtok * 512 + head * 64 + db * 32 + 8 * g4 + 4 * h, oy = (size_t)qtok * LD5 + head * 64 + db * 32 + 8 * g4 + 4 * h;
      const u32x2 gz = *(const u32x2*)(SZA + o);
      const float g0 = __uint_as_float(gz.x << 16), g1 = __uint_as_float(gz.x & 0xffff0000u), g2 = __uint_as_float(gz.y << 16), g3 = __uint_as_float(gz.y & 0xffff0000u);
      u32x2 w;
      w.x = pk2(O[db][4 * g4 + 0] * inv * g0, O[db][4 * g4 + 1] * inv * g1);
      w.y = pk2(O[db][4 * g4 + 2] * inv * g2, O[db][4 * g4 + 3] * inv * g3);
#ifdef PROBE_NO_ATTN
      w.x = 0; w.y = 0;
#endif
      *(u32x2*)(YA + oy) = w;
    }
}

DI void ph_mix(const Params& P, char* smem) {
  const bf16_t* U = (const bf16_t*)(P.ws + OFF_U);
  const bf16_t* HST = (const bf16_t*)(P.ws + OFF_HST);
  bf16_t* Y = (bf16_t*)(P.ws + OFF_S);
  float* st = (float*)smem;
  const int NU = 512 + 2048;
  for (int u = blockIdx.x; u < NU; u += gridDim.x) {
    if (u < 512) {
      const int nt = u & 1, mt = (u >> 1) & 7, g = u >> 4, m0 = mt * 256, n0 = nt * 256;
      f32x4v acc[8][4];
      gemm_main<ATwo, false>(acc, ATwo{U + (size_t)g * NCH * LD5, LD5, 64, HST + (size_t)g * NCH * LDQ, LDQ}, m0,
                             (const bf16_t*)(P.ws + OFF_WOUT) + (size_t)g * 512 * LDWO, LDWO, n0, 768, smem);
      EPI_ALL({
        _Pragma("unroll") for (int j = 0; j < 8; ++j) v[j] = geluf_(v[j]);
        st8bf(Y + ((size_t)g * NCH + m0 + lrow) * 512 + n0 + lc0, v); })
    } else {
      const int v2 = u - 512;
      const int head = v2 & 7, w = v2 >> 3;
      int tok0, L, qb;
      if (w < 128) { const int seq = w >> 6; qb = w & 63; tok0 = seq * 16384; L = 16384; }
      else { const int w2 = w - 128; const int seq = w2 >> 5; qb = w2 & 31; tok0 = 32768 + seq * 8192; L = 8192; }
      attn_unit(P, tok0, L, head, qb * 256, smem);
    }
  }
}

DI void ph_glu(const Params& P, char* smem) {
  const bf16_t* Y = (const bf16_t*)(P.ws + OFF_S);
  const bf16_t* SZS = (const bf16_t*)(P.ws + OFF_SZS);
  bf16_t* YS = (bf16_t*)(P.ws + OFF_U);
  float* st = (float*)smem;
  for (int u = blockIdx.x; u < 512; u += gridDim.x) {
    const int rnd = u >> 8, bb = u & 255, xcd = bb & 7, slot = bb >> 3;
    const int mt = rnd * 128 + xcd * 16 + (slot & 15), nt = slot >> 4, m0 = mt * 256, n0 = nt * 256;
    f32x4v acc[8][4];
    gemm_main<AGrp, false>(acc, AGrp{Y}, m0, (const bf16_t*)(P.ws + OFF_WGLU), LD5, n0, 512, smem);
    EPI_ALL({
      const int col = n0 + lc0, tok = m0 + lrow;
      float y[8], z[8], o[8];
      ld8bf(Y + ((size_t)(col >> 4) * MT + tok) * 16 + (col & 15), y);
      ld8bf(SZS + (size_t)tok * 512 + col, z);
      _Pragma("unroll") for (int j = 0; j < 8; ++j) o[j] = y[j] * sigmoidf_(v[j] + P.b_glu[col + j]) * z[j];
      st8bf(YS + (size_t)tok * LD5 + col, o); })
  }
}

DI void ph_merge(const Params& P, char* smem) {
  const bf16_t* YS = (const bf16_t*)(P.ws + OFF_U);
  const bf16_t* YA = (const bf16_t*)(P.ws + OFF_YA);
  const bf16_t* SGS = (const bf16_t*)(P.ws + OFF_SGS);
  const bf16_t* SGA = (const bf16_t*)(P.ws + OFF_SGA);
  bf16_t* MG = (bf16_t*)(P.ws + OFF_X0);
  float* st = (float*)smem;
  for (int u = blockIdx.x; u < 1024; u += gridDim.x) {
    const int rnd = u >> 8, bb = u & 255, xcd = bb & 7, slot = bb >> 3;
    const int mt = rnd * 64 + xcd * 8 + (slot & 7), nt = slot >> 3, m0 = mt * 256, n0 = nt * 256;
    f32x4v acc[8][4];
#pragma unroll 1
    for (int pass = 0; pass < 2; ++pass) {
      const bf16_t* A = pass ? YA : YS;
      const bf16_t* B = (const bf16_t*)(P.ws + (pass ? OFF_WBA : OFF_WBS));
      const bf16_t* G = pass ? SGA : SGS;
      gemm_main<ARow, false>(acc, ARow{A, LD5}, m0, B, LD5, n0, 512, smem);
      EPI_ALL({
        const size_t og = (size_t)(m0 + lrow) * 1024 + n0 + lc0, o = (size_t)(m0 + lrow) * LDX + n0 + lc0;
        float gte[8]; ld8bf(G + og, gte);
        _Pragma("unroll") for (int j = 0; j < 8; ++j) v[j] *= gte[j];
        if (pass) {
          float pr[8]; ld8bf(MG + o, pr);
          _Pragma("unroll") for (int j = 0; j < 8; ++j) v[j] += pr[j];
        }
        st8bf(MG + o, v); })
    }
  }
}

DI void wg_drain() {
  asm volatile("s_waitcnt vmcnt(0)" ::: "memory");
  __syncthreads();
  __builtin_amdgcn_fence(__ATOMIC_ACQUIRE, "agent");
  asm volatile("s_waitcnt vmcnt(0)" ::: "memory");
}
DI void ph_out(const Params& P, char* smem) {
  const bf16_t* MG = (const bf16_t*)(P.ws + OFF_X0);
  const float2* STATS = (const float2*)(P.ws + OFF_STATS);
  float* st = (float*)smem;
  for (int mt = blockIdx.x; mt < 256; mt += gridDim.x) {
    const int m0 = mt * 256;
#pragma unroll 1
    for (int nt = 0; nt < 4; ++nt) {
      const int n0 = nt * 256;
      f32x4v acc[8][4];
      gemm_main<ARow, false>(acc, ARow{MG, LDX}, m0, (const bf16_t*)(P.ws + OFF_WO), LDX, n0, 1024, smem);
      EPI_ALL({
        const int tok = m0 + lrow, col = n0 + lc0;
        const float* xp = tok < 32768 ? P.x_prompt + (size_t)tok * DM + col : P.x_sample + (size_t)(tok - 32768) * DM + col;
        float xv[8], gg[8], bb[8];
        ld8(xp, xv); ld8(P.ln_in_g + col, gg); ld8(P.ln_in_b + col, bb);
        const float2 stt = STATS[tok];
        _Pragma("unroll") for (int j = 0; j < 8; ++j) v[j] += ALPHA_RES * ((xv[j] - stt.x) * stt.y * gg[j] + bb[j]);
        float* d = P.out + (size_t)tok * DM + col;
        *(float4*)d = make_float4(v[0], v[1], v[2], v[3]); *(float4*)(d + 4) = make_float4(v[4], v[5], v[6], v[7]); })
    }
    wg_drain();
    {
      const int lane = tidx() & 63, wave = tidx() >> 6;
#pragma unroll 1
      for (int rs = 0; rs < 32; rs += 4) {
        const int row0 = m0 + wave * 32 + rs;
        float4 v[4][4];
#pragma unroll
        for (int rr = 0; rr < 4; ++rr)
#pragma unroll
          for (int i = 0; i < 4; ++i) v[rr][i] = *(const float4*)(P.out + (size_t)(row0 + rr) * DM + i * 256 + lane * 4);
#pragma unroll
        for (int rr = 0; rr < 4; ++rr) {
          float* zr = P.out + (size_t)(row0 + rr) * DM;
          float s = 0.f;
#pragma unroll
          for (int i = 0; i < 4; ++i) s += (v[rr][i].x + v[rr][i].y) + (v[rr][i].z + v[rr][i].w);
#pragma unroll
          for (int o = 32; o >= 1; o >>= 1) s += __shfl_xor(s, o);
          const float mu = s * (1.f / 1024.f);
          float q = 0.f;
#pragma unroll
          for (int i = 0; i < 4; ++i) { const float a = v[rr][i].x - mu, b = v[rr][i].y - mu, c = v[rr][i].z - mu, d = v[rr][i].w - mu; q += (a * a + b * b) + (c * c + d * d); }
#pragma unroll
          for (int o = 32; o >= 1; o >>= 1) q += __shfl_xor(q, o);
          const float rstd = rsqrtf(q * (1.f / 1024.f) + 1e-5f);
#pragma unroll
          for (int i = 0; i < 4; ++i) {
            const int c = i * 256 + lane * 4;
            const float4 g = *(const float4*)(P.ln_g + c), b = *(const float4*)(P.ln_b + c);
            float4 o;
            o.x = (v[rr][i].x - mu) * rstd * g.x + b.x; o.y = (v[rr][i].y - mu) * rstd * g.y + b.y;
            o.z = (v[rr][i].z - mu) * rstd * g.z + b.z; o.w = (v[rr][i].w - mu) * rstd * g.w + b.w;
            *(float4*)(zr + c) = o;
          }
        }
      }
    }
    __syncthreads();
  }
}

DI void ph_final_ln(const Params& P) {
  const int gt = blockIdx.x * blockDim.x + tidx(), gs = gridDim.x * blockDim.x;
  const int lane = tidx() & 63, gw = gt >> 6, nw = gs >> 6;
  for (int row0 = gw * 4; row0 < MT; row0 += nw * 4) {
    float4 v[4][4];
#pragma unroll
    for (int rr = 0; rr < 4; ++rr)
#pragma unroll
      for (int i = 0; i < 4; ++i) v[rr][i] = *(const float4*)(P.out + (size_t)(row0 + rr) * DM + i * 256 + lane * 4);
#pragma unroll
    for (int rr = 0; rr < 4; ++rr) {
      float* zr = P.out + (size_t)(row0 + rr) * DM;
      float s = 0.f;
#pragma unroll
      for (int i = 0; i < 4; ++i) s += (v[rr][i].x + v[rr][i].y) + (v[rr][i].z + v[rr][i].w);
#pragma unroll
      for (int o = 32; o >= 1; o >>= 1) s += __shfl_xor(s, o);
      const float mu = s * (1.f / 1024.f);
      float q = 0.f;
#pragma unroll
      for (int i = 0; i < 4; ++i) { const float a = v[rr][i].x - mu, b = v[rr][i].y - mu, c = v[rr][i].z - mu, d = v[rr][i].w - mu; q += (a * a + b * b) + (c * c + d * d); }
#pragma unroll
      for (int o = 32; o >= 1; o >>= 1) q += __shfl_xor(q, o);
      const float rstd = rsqrtf(q * (1.f / 1024.f) + 1e-5f);
#pragma unroll
      for (int i = 0; i < 4; ++i) {
        const int c = i * 256 + lane * 4;
        const float4 g = *(const float4*)(P.ln_g + c), b = *(const float4*)(P.ln_b + c);
        float4 o;
        o.x = (v[rr][i].x - mu) * rstd * g.x + b.x; o.y = (v[rr][i].y - mu) * rstd * g.y + b.y;
        o.z = (v[rr][i].z - mu) * rstd * g.z + b.z; o.w = (v[rr][i].w - mu) * rstd * g.w + b.w;
        *(float4*)(zr + c) = o;
      }
    }
  }
}

#define XB_TMO      128
#define XB_XCNT(j)  (256  + 64 * (j))
#define XB_XSUB(j)  (1280 + 64 * (j))
#define XB_XGEN(j)  (2304 + 64 * (j))
#define XB_TOP      3328
#define XB_TOPGEN   3392
#define XCD_BAR_WORDS 3456
#define XB_SPIN_CAP (1u << 22)
#define LAS __attribute__((address_space(3)))
DI unsigned xb_ld(unsigned* p) { return __hip_atomic_load(p, __ATOMIC_RELAXED, __HIP_MEMORY_SCOPE_AGENT); }
DI unsigned xb_add(unsigned* p, unsigned v) { return __hip_atomic_fetch_add(p, v, __ATOMIC_RELAXED, __HIP_MEMORY_SCOPE_AGENT); }
DI unsigned xb_xcc_id() { return (unsigned)__builtin_amdgcn_s_getreg((3 << 11) | 20) & 0xFu; }
#define XB_SPIN(cond, bar) do { unsigned _sp = 0; while (cond) { __builtin_amdgcn_s_sleep(1); \
    if ((++_sp & 255u) == 0u) { if (xb_ld(&(bar)[XB_TMO])) break; if (_sp > XB_SPIN_CAP) { atomicAdd(&(bar)[XB_TMO], 1u); break; } } } } while (0)
struct XcdBarrier { unsigned* bar; unsigned x; volatile LAS unsigned* st; };
DI XcdBarrier xcd_barrier_post(unsigned* bar, volatile LAS unsigned* st) {
  XcdBarrier b; b.bar = bar; b.x = xb_xcc_id(); b.st = st;
  if (threadIdx.x == 0) (void)xb_add(&bar[XB_XCNT(b.x)], 1u);
  return b;
}
DI void xcd_barrier_complete(unsigned* bar, unsigned x, unsigned& nloc, unsigned& nx) {
  const unsigned G = gridDim.x * gridDim.y * gridDim.z;
  unsigned sum, cnt, mine, sp = 0u;
  for (;;) {
    sum = 0u; cnt = 0u; mine = 0u;
#pragma unroll
    for (unsigned j = 0; j < 16; ++j) { const unsigned c = xb_ld(&bar[XB_XCNT(j)]); sum += c; cnt += (c > 0u) ? 1u : 0u; mine = (j == x) ? c : mine; }
    if (sum == G) break;
    __builtin_amdgcn_s_sleep(1);
    if ((++sp & 255u) == 0u) { if (xb_ld(&bar[XB_TMO])) break; if (sp > XB_SPIN_CAP) { atomicAdd(&bar[XB_TMO], 1u); break; } }
  }
  nloc = mine > 0u ? mine : 1u; nx = cnt > 0u ? cnt : 1u;
}
DI void xcd_barrier(const XcdBarrier& b) {
  asm volatile("s_waitcnt vmcnt(0)" ::: "memory");
  __syncthreads();
  if (threadIdx.x == 0) {
    unsigned* bar = b.bar;
    __builtin_amdgcn_s_waitcnt(0);
    unsigned nloc = b.st[0], nx = b.st[1];
    if (nloc == 0u) { xcd_barrier_complete(bar, b.x, nloc, nx); b.st[0] = nloc; b.st[1] = nx; }
    const unsigned old = xb_add(&bar[XB_XSUB(b.x)], 1u);
    const unsigned gen = old / nloc;
    if (old + 1u == (gen + 1u) * nloc) {
      __builtin_amdgcn_fence(__ATOMIC_RELEASE, "agent");
      asm volatile("s_waitcnt vmcnt(0)" ::: "memory");
      const unsigned og = xb_add(&bar[XB_TOP], 1u);
      const unsigned tg = og / nx;
      if (og + 1u == (tg + 1u) * nx) xb_add(&bar[XB_TOPGEN], 1u);
      else XB_SPIN(xb_ld(&bar[XB_TOPGEN]) == tg, bar);
      __builtin_amdgcn_fence(__ATOMIC_ACQUIRE, "agent");
      xb_add(&bar[XB_XGEN(b.x)], 1u);
      asm volatile("s_waitcnt vmcnt(0)" ::: "memory");
    } else {
      XB_SPIN(xb_ld(&bar[XB_XGEN(b.x)]) == gen, bar);
      __builtin_amdgcn_fence(__ATOMIC_ACQUIRE, "agent");
      asm volatile("s_waitcnt vmcnt(0)" ::: "memory");
    }
  }
  __syncthreads();
}

#ifndef N_LAUNCH_MODE
#define N_LAUNCH_MODE 1
#endif

template <int PH> DI void run_phase(const Params& P, char* smem) {
  if (PH == 0) ph_tables(P);
  else if (PH == 1) ph_prep(P, smem);
  else if (PH == 2) ph_g1(P, smem);
  else if (PH == 3) ph_qkv(P, smem);
  else if (PH == 4) ph_scan(P, smem);
  else if (PH == 5) ph_mix(P, smem);
  else if (PH == 6) ph_glu(P, smem);
  else if (PH == 7) ph_merge(P, smem);
  else if (PH == 8) ph_out(P, smem);
  else { }
}

#if N_LAUNCH_MODE == 1
__global__ void __launch_bounds__(512, 2) fwd_kernel(Params P_arg) {
  __shared__ __attribute__((aligned(1024))) char smem[SMEM_BYTES];
  cg::grid_group grid = cg::this_grid();
  const Params& P = *(const Params*)__builtin_amdgcn_kernarg_segment_ptr();
  if (threadIdx.x == 0) *(uint4*)(smem + OFF_XBW) = make_uint4(0u, 0u, 0u, 0u);
  __syncthreads();
  const XcdBarrier xb = xcd_barrier_post((unsigned*)(P.ws + OFF_BAR), (volatile LAS unsigned*)(smem + OFF_XBW));
  if (P.pad0 == 0x7fffffff) grid.sync();
#if defined(SPIN_PHASE) && SPIN_PHASE == 0
  { const unsigned long long t0_ = wall_clock64();
  run_phase<0>(P, smem);
  const unsigned long long t1_ = wall_clock64(); while (wall_clock64() - t1_ < t1_ - t0_) __builtin_amdgcn_s_sleep(8); }
#else
  run_phase<0>(P, smem);
#endif
  xcd_barrier(xb);
#if defined(SPIN_PHASE) && SPIN_PHASE == 1
  { const unsigned long long t0_ = wall_clock64();
  run_phase<1>(P, smem);
  const unsigned long long t1_ = wall_clock64(); while (wall_clock64() - t1_ < t1_ - t0_) __builtin_amdgcn_s_sleep(8); }
#else
  run_phase<1>(P, smem);
#endif
  xcd_barrier(xb);
#if defined(SPIN_PHASE) && SPIN_PHASE == 2
  { const unsigned long long t0_ = wall_clock64();
  run_phase<2>(P, smem);
  const unsigned long long t1_ = wall_clock64(); while (wall_clock64() - t1_ < t1_ - t0_) __builtin_amdgcn_s_sleep(8); }
#else
  run_phase<2>(P, smem);
#endif
  xcd_barrier(xb);
#if defined(SPIN_PHASE) && SPIN_PHASE == 3
  { const unsigned long long t0_ = wall_clock64();
  run_phase<3>(P, smem);
  const unsigned long long t1_ = wall_clock64(); while (wall_clock64() - t1_ < t1_ - t0_) __builtin_amdgcn_s_sleep(8); }
#else
  run_phase<3>(P, smem);
#endif
  xcd_barrier(xb);
#if defined(SPIN_PHASE) && SPIN_PHASE == 4
  { const unsigned long long t0_ = wall_clock64();
  run_phase<4>(P, smem);
  const unsigned long long t1_ = wall_clock64(); while (wall_clock64() - t1_ < t1_ - t0_) __builtin_amdgcn_s_sleep(8); }
#else
  run_phase<4>(P, smem);
#endif
  xcd_barrier(xb);
#if defined(SPIN_PHASE) && SPIN_PHASE == 5
  { const unsigned long long t0_ = wall_clock64();
  run_phase<5>(P, smem);
  const unsigned long long t1_ = wall_clock64(); while (wall_clock64() - t1_ < t1_ - t0_) __builtin_amdgcn_s_sleep(8); }
#else
  run_phase<5>(P, smem);
#endif
  xcd_barrier(xb);
#if defined(SPIN_PHASE) && SPIN_PHASE == 6
  { const unsigned long long t0_ = wall_clock64();
  run_phase<6>(P, smem);
  const unsigned long long t1_ = wall_clock64(); while (wall_clock64() - t1_ < t1_ - t0_) __builtin_amdgcn_s_sleep(8); }
#else
  run_phase<6>(P, smem);
#endif
  xcd_barrier(xb);
#if defined(SPIN_PHASE) && SPIN_PHASE == 7
  { const unsigned long long t0_ = wall_clock64();
  run_phase<7>(P, smem);
  const unsigned long long t1_ = wall_clock64(); while (wall_clock64() - t1_ < t1_ - t0_) __builtin_amdgcn_s_sleep(8); }
#else
  run_phase<7>(P, smem);
#endif
  xcd_barrier(xb);
#if defined(SPIN_PHASE) && SPIN_PHASE == 8
  { const unsigned long long t0_ = wall_clock64();
  run_phase<8>(P, smem);
  const unsigned long long t1_ = wall_clock64(); while (wall_clock64() - t1_ < t1_ - t0_) __builtin_amdgcn_s_sleep(8); }
#else
  run_phase<8>(P, smem);
#endif
}
#else
template <int PH> __global__ void __launch_bounds__(512, 2) phase_kernel(Params P) {
  __shared__ __attribute__((aligned(1024))) char smem[SMEM_BYTES];
  run_phase<PH>(P, smem);
}
#endif

extern "C" void kernel_launch(void* const* d_in, const int* in_sizes, int n_in, void* d_out, int out_size, void* d_ws, size_t ws_size, hipStream_t stream) {
  if (ws_size < WS_NEEDED) { fprintf(stderr, "workspace too small: %zu < %zu\n", ws_size, WS_NEEDED); return; }
  Params p{};
  const float** f = (const float**)&p;
  for (int i = 0; i < 29; ++i) f[i] = (const float*)d_in[i];
  p.out = (float*)d_out;
  p.ws = (char*)d_ws;
  static int grid_blocks = 0;
#if N_LAUNCH_MODE == 1
  if (!grid_blocks) {
    int dev = 0, cus = 0, per_cu = 0;
    (void)hipGetDevice(&dev);
    (void)hipDeviceGetAttribute(&cus, hipDeviceAttributeMultiprocessorCount, dev);
    (void)hipOccupancyMaxActiveBlocksPerMultiprocessor(&per_cu, fwd_kernel, NTHR, 0);
    if (per_cu > 1) per_cu = 1;
    if (per_cu < 1) per_cu = 1;
    grid_blocks = cus * per_cu;
  }
  (void)hipMemsetAsync((char*)d_ws + OFF_BAR, 0, XCD_BAR_WORDS * sizeof(unsigned), stream);
  void* args[] = {&p};
  hipError_t e = hipLaunchCooperativeKernel((void*)fwd_kernel, dim3(grid_blocks), dim3(NTHR), args, 0, stream);
  if (e != hipSuccess) fprintf(stderr, "cooperative launch failed: %s (grid %d)\n", hipGetErrorString(e), grid_blocks);
#else
  grid_blocks = 256;
  hipLaunchKernelGGL(phase_kernel<0>, dim3(grid_blocks), dim3(NTHR), 0, stream, p);
#if defined(DUP_MASK)
  if ((DUP_MASK >> 0) & 1) hipLaunchKernelGGL(phase_kernel<0>, dim3(grid_blocks), dim3(NTHR), 0, stream, p);
#endif
  hipLaunchKernelGGL(phase_kernel<1>, dim3(grid_blocks), dim3(NTHR), 0, stream, p);
#if defined(DUP_MASK)
  if ((DUP_MASK >> 1) & 1) hipLaunchKernelGGL(phase_kernel<1>, dim3(grid_blocks), dim3(NTHR), 0, stream, p);
#endif
  hipLaunchKernelGGL(phase_kernel<2>, dim3(grid_blocks), dim3(NTHR), 0, stream, p);
#if defined(DUP_MASK)
  if ((DUP_MASK >> 2) & 1) hipLaunchKernelGGL(phase_kernel<2>, dim3(grid_blocks), dim3(NTHR), 0, stream, p);
#endif
  hipLaunchKernelGGL(phase_kernel<3>, dim3(grid_blocks), dim3(NTHR), 0, stream, p);
#if defined(DUP_MASK)
  if ((DUP_MASK >> 3) & 1) hipLaunchKernelGGL(phase_kernel<3>, dim3(grid_blocks), dim3(NTHR), 0, stream, p);
#endif
  hipLaunchKernelGGL(phase_kernel<4>, dim3(grid_blocks), dim3(NTHR), 0, stream, p);
#if defined(DUP_MASK)
  if ((DUP_MASK >> 4) & 1) hipLaunchKernelGGL(phase_kernel<4>, dim3(grid_blocks), dim3(NTHR), 0, stream, p);
#endif
  hipLaunchKernelGGL(phase_kernel<5>, dim3(grid_blocks), dim3(NTHR), 0, stream, p);
#if defined(DUP_MASK)
  if ((DUP_MASK >> 5) & 1) hipLaunchKernelGGL(phase_kernel<5>, dim3(grid_blocks), dim3(NTHR), 0, stream, p);
#endif
  hipLaunchKernelGGL(phase_kernel<6>, dim3(grid_blocks), dim3(NTHR), 0, stream, p);
#if defined(DUP_MASK)
  if ((DUP_MASK >> 6) & 1) hipLaunchKernelGGL(phase_kernel<6>, dim3(grid_blocks), dim3(NTHR), 0, stream, p);
#endif
  hipLaunchKernelGGL(phase_kernel<7>, dim3(grid_blocks), dim3(NTHR), 0, stream, p);
#if defined(DUP_MASK)
  if ((DUP_MASK >> 7) & 1) hipLaunchKernelGGL(phase_kernel<7>, dim3(grid_blocks), dim3(NTHR), 0, stream, p);
#endif
  hipLaunchKernelGGL(phase_kernel<8>, dim3(grid_blocks), dim3(NTHR), 0, stream, p);
#if defined(DUP_MASK)
  if ((DUP_MASK >> 8) & 1) hipLaunchKernelGGL(phase_kernel<8>, dim3(grid_blocks), dim3(NTHR), 0, stream, p);
#endif
#endif
}
```
